# Optimizing an MI355X kernel written in HIP

```python
import jax, jax.numpy as jnp
from jax import lax
import numpy as np

D_MODEL = 2048
BATCH = 4
SEQ = 2048
DEPTH = 4
DEC_BATCH = 128
DEC_SEQ = 1
PAST_LEN = 16384
PAGE_SIZE = 128

MIX_WIDTH = D_MODEL
A_WIDTH = MIX_WIDTH // 2
B_WIDTH = MIX_WIDTH - A_WIDTH
A_HEADS = 8
A_HEAD_DIM = A_WIDTH // A_HEADS
A_CHUNK = 128
B_HEADS = 8
B_KEY_DIM = 128
B_VAL_DIM = B_WIDTH // B_HEADS
B_QF_WIDTH = B_HEADS * B_KEY_DIM
B_CHUNK = 64
D_FF = -(-8 * D_MODEL // (3 * 256)) * 256
IN_WIDTH = 2 * A_WIDTH + 2 * B_QF_WIDTH + 2 * B_WIDTH
SPLITS = [A_WIDTH, 2 * A_WIDTH, 2 * A_WIDTH + B_QF_WIDTH, 2 * A_WIDTH + 2 * B_QF_WIDTH,
          2 * A_WIDTH + 2 * B_QF_WIDTH + B_WIDTH]
EPS = 1e-6

kernel_name = "hybrid_gmlp_hgrn2_decode_step"


def rms_norm(x, g):
    x32 = x.astype(jnp.float32)
    y = x32 * lax.rsqrt(jnp.mean(x32 * x32, axis=-1, keepdims=True) + EPS)
    return (y * g.astype(jnp.float32)).astype(x.dtype)


def layer_norm(x, g, b):
    x32 = x.astype(jnp.float32)
    mu = jnp.mean(x32, axis=-1, keepdims=True)
    xc = x32 - mu
    y = xc * lax.rsqrt(jnp.mean(xc * xc, axis=-1, keepdims=True) + EPS)
    return (y * g.astype(jnp.float32) + b.astype(jnp.float32)).astype(x.dtype)


def chunk_spatial_gating(u, v, w_s, b_s):
    bn, L, _ = v.shape
    pad = (-L) % A_CHUNK
    n = (L + pad) // A_CHUNK
    vp = jnp.pad(v, ((0, 0), (0, pad), (0, 0))).reshape(bn, n, A_CHUNK, A_HEADS, A_HEAD_DIM)
    mask = jnp.tril(jnp.ones((A_CHUNK, A_CHUNK), dtype=bool))
    w = jnp.where(mask, w_s, 0.0).astype(v.dtype)
    s = jnp.einsum('hts,bnshd->bnthd', w, vp) + b_s.T[:, :, None].astype(v.dtype)
    s = s.reshape(bn, n * A_CHUNK, A_WIDTH)[:, :L]
    return u * s


def hgrn2_recurrence(q, z_f, i_in, S0, lb):
    bn, L = q.shape[0], q.shape[1]
    z = z_f.astype(jnp.float32)
    lb = lb.astype(jnp.float32)
    logf = jnp.logaddexp(jnp.log(lb), jnp.log1p(-lb) + jax.nn.log_sigmoid(z))
    k = (1.0 - lb) * jax.nn.sigmoid(-z)
    qf = jax.nn.silu(q.astype(jnp.float32))
    vf = i_in.astype(jnp.float32)
    C = min(B_CHUNK, L)
    pad = (-L) % C
    n = (L + pad) // C

    def to_chunks(a):
        a = jnp.pad(a, ((0, 0), (0, pad), (0, 0), (0, 0)))
        return jnp.moveaxis(a.reshape(bn, n, C, a.shape[2], a.shape[3]), 1, 0)

    qc, lfc, kc, vc = to_chunks(qf), to_chunks(logf), to_chunks(k), to_chunks(vf)
    mask = jnp.tril(jnp.ones((C, C), dtype=bool))[None, :, :, None, None]

    def step(S, inp):
        qb, lfb, kb, vb = inp
        bcum = jnp.cumsum(lfb, axis=1)
        o_inter = jnp.einsum('bthk,bhkv->bthv', qb * jnp.exp(bcum), S)
        diff = bcum[:, :, None] - bcum[:, None, :]
        decay = jnp.exp(jnp.where(mask, diff, -jnp.inf))
        attn = jnp.einsum('bthk,btshk,bshk->btsh', qb, decay, kb)
        o_intra = jnp.einsum('btsh,bshv->bthv', attn, vb)
        blast = bcum[:, -1]
        S_new = jnp.exp(blast)[..., None] * S + jnp.einsum(
            'bshk,bshv->bhkv', kb * jnp.exp(blast[:, None] - bcum), vb)
        return S_new, o_inter + o_intra

    S_fin, o = lax.scan(step, S0.astype(jnp.float32), (qc, lfc, kc, vc))
    o = jnp.moveaxis(o, 0, 1).reshape(bn, n * C, B_HEADS, B_VAL_DIM)[:, :L]
    return o, S_fin


def trunk_layer(x, S0, lb, g_mix_pre, g_mix_post, w_in, ln_g, ln_b, w_s, b_s,
                g_out, w_out, g_ffn_pre, g_ffn_post, w_gate, w_up, w_down):
    bn, L, _ = x.shape
    h = rms_norm(x, g_mix_pre)
    proj = h @ w_in.astype(x.dtype)
    u, v, q, zf, ib, g = jnp.split(proj, SPLITS, axis=-1)
    u = jax.nn.gelu(u, approximate=False)
    v = layer_norm(jax.nn.gelu(v, approximate=False), ln_g, ln_b)
    o_a = chunk_spatial_gating(u, v, w_s, b_s)
    v_rows = v[:, ((L - 1) // A_CHUNK) * A_CHUNK:]
    o_b, S_new = hgrn2_recurrence(q.reshape(bn, L, B_HEADS, B_KEY_DIM),
                                  zf.reshape(bn, L, B_HEADS, B_KEY_DIM),
                                  ib.reshape(bn, L, B_HEADS, B_VAL_DIM), S0, lb)
    o_b = o_b * lax.rsqrt(jnp.mean(o_b * o_b, axis=-1, keepdims=True) + EPS)
    o_b = o_b * g_out.astype(jnp.float32).reshape(B_HEADS, B_VAL_DIM)
    o_b = (o_b.reshape(bn, L, B_WIDTH) * jax.nn.silu(g.astype(jnp.float32))).astype(x.dtype)
    mix = jnp.concatenate([o_a, o_b], axis=-1) @ w_out.astype(x.dtype)
    x = x + rms_norm(mix, g_mix_post)
    h = rms_norm(x, g_ffn_pre)
    f = (jax.nn.silu(h @ w_gate.astype(x.dtype)) * (h @ w_up.astype(x.dtype))) @ w_down.astype(x.dtype)
    x = x + rms_norm(f, g_ffn_post)
    return x, S_new, v_rows


def setup_inputs(seed: int = 0) -> dict:
    key = jax.random.key(seed)
    ks = jax.random.split(key, 20)
    nrm = jax.random.normal
    f32 = jnp.float32
    return {
        "x_prompt": nrm(ks[0], (BATCH, SEQ, D_MODEL), f32),
        "x_sample": nrm(ks[1], (DEC_BATCH, DEC_SEQ, D_MODEL), f32),
        "state_hgrn": nrm(ks[2], (DEPTH, DEC_BATCH, B_HEADS, B_KEY_DIM, B_VAL_DIM), f32),
        "norm_mix_pre": 1.0 + 0.05 * nrm(ks[3], (DEPTH, D_MODEL), f32),
        "norm_mix_post": 1.0 + 0.05 * nrm(ks[4], (DEPTH, D_MODEL), f32),
        "w_in": nrm(ks[5], (DEPTH, D_MODEL, IN_WIDTH), f32) * D_MODEL ** -0.5,
        "ln_v_gain": 1.0 + 0.05 * nrm(ks[6], (DEPTH, A_WIDTH), f32),
        "ln_v_bias": 0.02 * nrm(ks[7], (DEPTH, A_WIDTH), f32),
        "spatial_w": nrm(ks[8], (DEPTH, A_HEADS, A_CHUNK, A_CHUNK), f32) * A_CHUNK ** -0.5,
        "spatial_b": 1.0 + 0.1 * nrm(ks[9], (DEPTH, A_HEADS, A_CHUNK), f32),
        "lb_param": 0.5 * nrm(ks[10], (DEPTH, B_QF_WIDTH), f32),
        "hgrn_out_gain": 1.0 + 0.05 * nrm(ks[11], (DEPTH, B_WIDTH), f32),
        "w_out": nrm(ks[12], (DEPTH, MIX_WIDTH, D_MODEL), f32) * MIX_WIDTH ** -0.5,
        "norm_ffn_pre": 1.0 + 0.05 * nrm(ks[13], (DEPTH, D_MODEL), f32),
        "norm_ffn_post": 1.0 + 0.05 * nrm(ks[14], (DEPTH, D_MODEL), f32),
        "w_gate": nrm(ks[15], (DEPTH, D_MODEL, D_FF), f32) * D_MODEL ** -0.5,
        "w_up": nrm(ks[16], (DEPTH, D_MODEL, D_FF), f32) * D_MODEL ** -0.5,
        "w_down": nrm(ks[17], (DEPTH, D_FF, D_MODEL), f32) * D_FF ** -0.5,
    }


def reference(x_prompt, x_sample, state_hgrn, norm_mix_pre, norm_mix_post, w_in,
              ln_v_gain, ln_v_bias, spatial_w, spatial_b, lb_param, hgrn_out_gain,
              w_out, norm_ffn_pre, norm_ffn_post, w_gate, w_up, w_down):
    lb_cum = jnp.cumsum(jax.nn.softmax(lb_param.astype(jnp.float32), axis=0), axis=0)
    lb_all = (lb_cum - lb_cum[0:1]).reshape(DEPTH, B_HEADS, B_KEY_DIM)

    def run(x, S_in):
        S_out, v_out = [], []
        for l in range(DEPTH):
            x, S_l, v_l = trunk_layer(
                x, S_in[l], lb_all[l], norm_mix_pre[l], norm_mix_post[l], w_in[l],
                ln_v_gain[l], ln_v_bias[l], spatial_w[l], spatial_b[l], hgrn_out_gain[l],
                w_out[l], norm_ffn_pre[l], norm_ffn_post[l], w_gate[l], w_up[l], w_down[l])
            S_out.append(S_l.astype(S_in.dtype))
            v_out.append(v_l)
        return x, jnp.stack(S_out), jnp.stack(v_out)

    S_zero = jnp.zeros((DEPTH, BATCH, B_HEADS, B_KEY_DIM, B_VAL_DIM), state_hgrn.dtype)
    y_prompt, state_hgrn_prompt, state_v_prompt = run(x_prompt, S_zero)
    y_sample, state_hgrn_sample, state_v_sample = run(x_sample, state_hgrn)
    return (y_prompt, y_sample, state_hgrn_prompt, state_hgrn_sample, state_v_prompt, state_v_sample)
```

```cpp
#include <hip/hip_runtime.h>
#include <cstdio>
#include <cstdint>
namespace pg8 {
#define PG8_LAS __attribute__((address_space(3)))
typedef unsigned short bf16_t;
typedef short bf16x8 __attribute__((ext_vector_type(8)));
typedef float f32x4 __attribute__((ext_vector_type(4)));
typedef unsigned u32x4 __attribute__((ext_vector_type(4)));
constexpr int BM = 256, BK = 64, HALF = 128, HTB = HALF * BK * 2  , STAGE_BYTES = 8 * HTB, NXCD = 8, WGM = 8;

__host__ __device__ __forceinline__ int lds_byte(int r, int c) { const int st = (r >> 4) * 2 + (c >> 5), rr = r & 15, cc = c & 31, ob = rr * 64 + cc * 2; return st * 1024 + (ob ^ (((ob >> 9) & 1) << 5)); }
__host__ __device__ __forceinline__ void stage_rc(int b, int& R, int& C) { const int st = b / 1024, sb = b % 1024, swz = sb ^ (((sb >> 9) & 1) << 5); R = (st >> 1) * 16 + swz / 64; C = (st & 1) * 32 + (swz % 64) / 2; }
__host__ __device__ __forceinline__ int perm32(int rho) { const int n = rho >> 4, i = rho & 15; return 8 * (i >> 2) + 4 * n + (i & 3); }

struct Unit { int pm, pn; };
struct Gemm { const bf16_t* A; const bf16_t* Bt; int M, N, K; };

struct StaticOrder {
    int nM, nN, nwg, G, c;
    __host__ __device__ void init(int M, int N, int G_, int c_) { nM = M / BM; nN = N / BM; nwg = nM * nN; G = G_; c = c_; }
    __host__ __device__ __forceinline__ bool next(int i, Unit& u) const {
        const long L = (long)i * G + c; if (L >= nwg) return false;
        int wgid = (int)L; { const int q = nwg / NXCD, r = nwg % NXCD, xcd = wgid % NXCD, off = wgid / NXCD; wgid = (xcd < r ? xcd * (q + 1) : r * (q + 1) + (xcd - r) * q) + off; }
        const int nig = WGM * nN, gid = wgid / nig, fm = gid * WGM, gsz = (nM - fm) < WGM ? (nM - fm) : WGM;
        u.pm = fm + ((wgid % nig) % gsz); u.pn = (wgid % nig) / gsz; return true;
    }
    __device__ __forceinline__ void a_ready(const Unit&) const {}
    __device__ __forceinline__ void done(const Unit&) const {}
};

typedef float f32x2c_t __attribute__((ext_vector_type(2))); typedef __bf16 bf16x2c_t __attribute__((ext_vector_type(2)));
__device__ __forceinline__ unsigned cvt_pk_bf16(float lo, float hi) { f32x2c_t v = {lo, hi}; bf16x2c_t b = __builtin_convertvector(v, bf16x2c_t); return __builtin_bit_cast(unsigned, b); }
typedef float f32x2 __attribute__((ext_vector_type(2)));
__device__ __forceinline__ f32x2 gelu_pk(f32x2 v) {
    const f32x2 av = __builtin_elementwise_abs(v), d = av * 0.2316418882f + 1.0f;
    f32x2 t; t.x = __builtin_amdgcn_rcpf(d.x); t.y = __builtin_amdgcn_rcpf(d.y);
    f32x2 q = t * 0.5307027145f + (-0.7265760135f); q = q * t + 0.7107068705f; q = q * t + (-0.142248368f); q = q * t + 0.127414796f; q = q * t;
    const f32x2 s = (v * v) * (-0.72134752044f);
    f32x2 e; e.x = __builtin_amdgcn_exp2f(s.x); e.y = __builtin_amdgcn_exp2f(s.y);
    const f32x2 m = v * (q * e), r = v - m;
    f32x2 o; o.x = v.x < 0.f ? m.x : r.x; o.y = v.y < 0.f ? m.y : r.y; return o;
}
__device__ __forceinline__ float silu_f(float x) { return x * __builtin_amdgcn_rcpf(1.0f + __expf(-x)); }
struct EpiIn {
    static constexpr bool PERM = true, AFTER_DRAIN = false;
    bf16_t* P; float* ZF;
    __device__ __forceinline__ void operator()(const f32x4 (&acc)[2][2][4][2], const Unit& u, int wr, int wc, int fr, int fq) const {
        const int typ = u.pn >> 2;
        const int row0 = u.pm * BM + wr * 64 + fr, col0 = u.pn * BM + wc * 32 + 8 * fq;
        if (typ == 3) {
#pragma unroll
            for (int ai = 0; ai < 2; ++ai)
#pragma unroll
                for (int m = 0; m < 4; ++m) { float* rowp = ZF + (size_t)(row0 + ai * HALF + m * 16) * 1024 + (col0 - 3072);
#pragma unroll
                    for (int bj = 0; bj < 2; ++bj) { *(f32x4*)(rowp + bj * HALF) = acc[ai][bj][m][0]; *(f32x4*)(rowp + bj * HALF + 4) = acc[ai][bj][m][1]; } }
        } else {
#pragma unroll
            for (int ai = 0; ai < 2; ++ai)
#pragma unroll
                for (int m = 0; m < 4; ++m) { bf16_t* rowp = P + (size_t)(row0 + ai * HALF + m * 16) * 6144 + col0;
#pragma unroll
                    for (int bj = 0; bj < 2; ++bj) { f32x4 v0 = acc[ai][bj][m][0], v1 = acc[ai][bj][m][1];
                        if (typ <= 1) { f32x2 a = gelu_pk((f32x2){v0[0], v0[1]}), b = gelu_pk((f32x2){v0[2], v0[3]}), c = gelu_pk((f32x2){v1[0], v1[1]}), d = gelu_pk((f32x2){v1[2], v1[3]});
                            v0 = (f32x4){a.x, a.y, b.x, b.y}; v1 = (f32x4){c.x, c.y, d.x, d.y}; }
                        else if (typ != 4) { v0 = (f32x4){silu_f(v0[0]), silu_f(v0[1]), silu_f(v0[2]), silu_f(v0[3])}; v1 = (f32x4){silu_f(v1[0]), silu_f(v1[1]), silu_f(v1[2]), silu_f(v1[3])}; }
                        u32x4 w; w.x = cvt_pk_bf16(v0[0], v0[1]); w.y = cvt_pk_bf16(v0[2], v0[3]); w.z = cvt_pk_bf16(v1[0], v1[1]); w.w = cvt_pk_bf16(v1[2], v1[3]);
                        *(u32x4*)(rowp + bj * HALF) = w; } }
        }
    }
};
struct EpiF32 {
    static constexpr bool PERM = false, AFTER_DRAIN = false;
    float* O; int ldc;
    __device__ __forceinline__ void operator()(const f32x4 (&acc)[2][2][4][2], const Unit& u, int wr, int wc, int fr, int fq) const {
        const int row0 = u.pm * BM + wr * 64 + fr, col0 = u.pn * BM + wc * 32 + 4 * fq;
#pragma unroll
        for (int ai = 0; ai < 2; ++ai)
#pragma unroll
            for (int m = 0; m < 4; ++m) { float* rowp = O + (size_t)(row0 + ai * HALF + m * 16) * ldc + col0;
#pragma unroll
                for (int bj = 0; bj < 2; ++bj)
#pragma unroll
                    for (int n = 0; n < 2; ++n) *(f32x4*)(rowp + bj * HALF + n * 16) = acc[ai][bj][m][n]; }
    }
};
struct EpiGU {
    static constexpr bool PERM = true, AFTER_DRAIN = false;
    bf16_t* O; int ldc;
    __device__ __forceinline__ void operator()(const f32x4 (&acc)[2][2][4][2], const Unit& u, int wr, int wc, int fr, int fq) const {
        const int row0 = u.pm * BM + wr * 64 + fr, col0 = u.pn * HALF + wc * 32 + 8 * fq;
#pragma unroll
        for (int ai = 0; ai < 2; ++ai)
#pragma unroll
            for (int m = 0; m < 4; ++m) { bf16_t* rowp = O + (size_t)(row0 + ai * HALF + m * 16) * ldc + col0;
                const f32x4 g0 = acc[ai][0][m][0], g1 = acc[ai][0][m][1], u0 = acc[ai][1][m][0], u1 = acc[ai][1][m][1];
                u32x4 w; w.x = cvt_pk_bf16(silu_f(g0[0]) * u0[0], silu_f(g0[1]) * u0[1]); w.y = cvt_pk_bf16(silu_f(g0[2]) * u0[2], silu_f(g0[3]) * u0[3]);
                w.z = cvt_pk_bf16(silu_f(g1[0]) * u1[0], silu_f(g1[1]) * u1[1]); w.w = cvt_pk_bf16(silu_f(g1[2]) * u1[2], silu_f(g1[3]) * u1[3]);
                *(u32x4*)rowp = w; }
    }
};
struct EpiB16 {
    static constexpr bool PERM = true, AFTER_DRAIN = false;
    bf16_t* O; int ldc;
    __device__ __forceinline__ void operator()(const f32x4 (&acc)[2][2][4][2], const Unit& u, int wr, int wc, int fr, int fq) const {
        const int row0 = u.pm * BM + wr * 64 + fr, col0 = u.pn * BM + wc * 32 + 8 * fq;
#pragma unroll
        for (int ai = 0; ai < 2; ++ai)
#pragma unroll
            for (int m = 0; m < 4; ++m) { bf16_t* rowp = O + (size_t)(row0 + ai * HALF + m * 16) * ldc + col0;
#pragma unroll
                for (int bj = 0; bj < 2; ++bj) { const f32x4 v0 = acc[ai][bj][m][0], v1 = acc[ai][bj][m][1];
                    u32x4 w; w.x = cvt_pk_bf16(v0[0], v0[1]); w.y = cvt_pk_bf16(v0[2], v0[3]); w.z = cvt_pk_bf16(v1[0], v1[1]); w.w = cvt_pk_bf16(v1[2], v1[3]);
                    *(u32x4*)(rowp + bj * HALF) = w; } }
    }
};
struct EpiB16WT {
    static constexpr bool PERM = true, AFTER_DRAIN = false;
    bf16_t* O; int ldc;
    __device__ __forceinline__ void operator()(const f32x4 (&acc)[2][2][4][2], const Unit& u, int wr, int wc, int fr, int fq) const {
        const int row0 = u.pm * BM + wr * 64 + fr, col0 = u.pn * BM + wc * 32 + 8 * fq;
        const __amdgpu_buffer_rsrc_t r = __builtin_amdgcn_make_buffer_rsrc((void*)O, (short)0, 0x7fffffff, 0x00020000);
#pragma unroll
        for (int ai = 0; ai < 2; ++ai)
#pragma unroll
            for (int m = 0; m < 4; ++m) { const size_t ro = ((size_t)(row0 + ai * HALF + m * 16) * ldc + col0) * 2;
#pragma unroll
                for (int bj = 0; bj < 2; ++bj) { const f32x4 v0 = acc[ai][bj][m][0], v1 = acc[ai][bj][m][1];
                    u32x4 w; w.x = cvt_pk_bf16(v0[0], v0[1]); w.y = cvt_pk_bf16(v0[2], v0[3]); w.z = cvt_pk_bf16(v1[0], v1[1]); w.w = cvt_pk_bf16(v1[2], v1[3]);
                    __builtin_amdgcn_raw_buffer_store_b128(w, r, (unsigned)(ro + bj * HALF * 2), 0, 16); } }
    }
};
template <class Epi, class Sched, bool ALIGN_EPI = false, bool SP2 = false>
__device__ __forceinline__ void gemm_phase(PG8_LAS unsigned char* lds, const Gemm g, const Sched& S, const Epi& E) {
    const int tid = threadIdx.x, wid = __builtin_amdgcn_readfirstlane(tid >> 6), lane = tid & 63, wr = wid >> 2, wc = wid & 3, fr = lane & 15, fq = lane >> 4;
    const int K = g.K, nt = K / BK;
    unsigned voffA[2], voffB[2];
#pragma unroll
    for (int i = 0; i < 2; ++i) { int R, C; stage_rc(tid * 16 + i * 8192, R, C); const int Rb = Epi::PERM ? ((R & ~31) + perm32(R & 31)) : R;
        voffA[i] = (unsigned)(R * K + C) * 2u; voffB[i] = (unsigned)(Rb * K + C) * 2u; }
    const size_t kstep = (size_t)(BK * 2);
    const size_t hstep = (size_t)HALF * K * 2;
    const size_t tstep = 2 * hstep;
    const unsigned ldsw = (unsigned)wid * 1024u;
    const int aoff = lds_byte(wr * 64 + fr, fq * 8), boff = lds_byte(wc * 32 + fr, fq * 8);
#define PG8_SA(b, h) (((b) * 2 + (h)) * HTB)
#define PG8_SB(b, h) ((4 + (b) * 2 + (h)) * HTB)
#define PG8_STAGE(bufoff, gbase, voff) do { _Pragma("unroll") for (int _i = 0; _i < 2; ++_i) \
        __builtin_amdgcn_global_load_lds((const unsigned*)((const char*)(gbase) + (voff)[_i]), (PG8_LAS unsigned*)(lds + (bufoff) + ldsw + _i * 8192), 16, 0, 0); } while (0)
#define PG8_LDA(dst, b, h) do { _Pragma("unroll") for (int m = 0; m < 4; ++m) _Pragma("unroll") for (int k = 0; k < 2; ++k) dst[m][k] = *(const PG8_LAS bf16x8*)(lds + PG8_SA(b, h) + aoff + m * 2048 + k * 1024); } while (0)
#define PG8_LDB(dst, b, h) do { _Pragma("unroll") for (int n = 0; n < 2; ++n) _Pragma("unroll") for (int k = 0; k < 2; ++k) dst[n][k] = *(const PG8_LAS bf16x8*)(lds + PG8_SB(b, h) + boff + n * 2048 + k * 1024); } while (0)
#define PG8_MMA(ai, bj, At, Bt) do { __builtin_amdgcn_s_setprio(1); _Pragma("unroll") for (int m = 0; m < 4; ++m) _Pragma("unroll") for (int n = 0; n < 2; ++n) _Pragma("unroll") for (int k = 0; k < 2; ++k) \
        acc[ai][bj][m][n] = __builtin_amdgcn_mfma_f32_16x16x32_bf16(Bt[n][k], At[m][k], acc[ai][bj][m][n], 0, 0, 0); __builtin_amdgcn_s_setprio(0); } while (0)
#define PG8_WAIT_V(n) asm volatile("s_waitcnt vmcnt(" #n ")" ::: "memory")
#define PG8_WAIT_L(n) asm volatile("s_waitcnt lgkmcnt(" #n ")" ::: "memory")
#define PG8_BAR __builtin_amdgcn_s_barrier()
#define PG8_SCHED __builtin_amdgcn_sched_barrier(0)
    Unit cur, nxt; int ui = 0;
    if (!S.next(0, cur)) return;
    f32x4 acc[2][2][4][2];
#pragma unroll
    for (int a = 0; a < 2; ++a)
#pragma unroll
        for (int b = 0; b < 2; ++b)
#pragma unroll
            for (int m = 0; m < 4; ++m)
#pragma unroll
                for (int n = 0; n < 2; ++n) acc[a][b][m][n] = (f32x4){0.f, 0.f, 0.f, 0.f};
    bf16x8 At[4][2], B0[2][2], B1[2][2];
    const char* cA = (const char*)g.A + (size_t)cur.pm * tstep; const char* cB = (const char*)g.Bt + (size_t)cur.pn * tstep;
    S.a_ready(cur);
    if constexpr (SP2) {
        PG8_STAGE(PG8_SB(0, 0), cB, voffB); PG8_STAGE(PG8_SB(0, 1), cB + hstep, voffB); PG8_STAGE(PG8_SA(0, 0), cA, voffA); PG8_STAGE(PG8_SA(0, 1), cA + hstep, voffA);
        if (wr == 1) PG8_BAR;
        PG8_WAIT_V(2); PG8_BAR;
        PG8_STAGE(PG8_SB(1, 0), cB + kstep, voffB); PG8_STAGE(PG8_SA(1, 0), cA + kstep, voffA); PG8_STAGE(PG8_SB(1, 1), cB + hstep + kstep, voffB);
        PG8_WAIT_V(6); PG8_BAR;
    } else {
        PG8_STAGE(PG8_SB(0, 0), cB, voffB); PG8_STAGE(PG8_SA(0, 0), cA, voffA); PG8_STAGE(PG8_SB(0, 1), cB + hstep, voffB); PG8_STAGE(PG8_SA(0, 1), cA + hstep, voffA);
        if (wr == 1) PG8_BAR;
        PG8_WAIT_V(4); PG8_BAR;
        PG8_STAGE(PG8_SB(1, 0), cB + kstep, voffB); PG8_STAGE(PG8_SA(1, 0), cA + kstep, voffA); PG8_STAGE(PG8_SB(1, 1), cB + hstep + kstep, voffB);
        PG8_WAIT_V(6); PG8_BAR;
    }
    for (;;) {
        const bool has_next = S.next(ui + 1, nxt);
        const char* nA = has_next ? (const char*)g.A + (size_t)nxt.pm * tstep : cA; const char* nB = has_next ? (const char*)g.Bt + (size_t)nxt.pn * tstep : cB;
        for (int t = 0; t < nt; t += 2) {
            const bool last = (t == nt - 2);
            const char* a1 = cA + (size_t)(t + 1) * kstep;
            const char* a2 = last ? nA : cA + (size_t)(t + 2) * kstep; const char* b2 = last ? nB : cB + (size_t)(t + 2) * kstep;
            const char* a3 = a2 + kstep; const char* b3 = b2 + kstep;
            if (last && has_next) S.a_ready(nxt);
            if constexpr (SP2) {
            PG8_LDB(B0, 0, 0); PG8_LDB(B1, 0, 1); PG8_SCHED; PG8_LDA(At, 0, 0); PG8_STAGE(PG8_SA(1, 1), a1 + hstep, voffA);
            PG8_WAIT_V(8); PG8_WAIT_L(0); PG8_BAR; PG8_MMA(0, 0, At, B0); PG8_MMA(0, 1, At, B1); PG8_BAR; PG8_SCHED;
            PG8_LDA(At, 0, 1); PG8_STAGE(PG8_SB(0, 0), b2, voffB); PG8_STAGE(PG8_SB(0, 1), b2 + hstep, voffB); PG8_STAGE(PG8_SA(0, 0), a2, voffA);
            PG8_WAIT_V(8); PG8_WAIT_L(0); PG8_BAR; PG8_MMA(1, 0, At, B0); PG8_MMA(1, 1, At, B1); PG8_BAR; PG8_SCHED;
            PG8_LDB(B0, 1, 0); PG8_LDB(B1, 1, 1); PG8_SCHED; PG8_LDA(At, 1, 0); PG8_STAGE(PG8_SA(0, 1), a2 + hstep, voffA);
            PG8_WAIT_V(8); PG8_WAIT_L(0); PG8_BAR; PG8_MMA(0, 0, At, B0); PG8_MMA(0, 1, At, B1); PG8_BAR; PG8_SCHED;
            PG8_LDA(At, 1, 1); PG8_STAGE(PG8_SB(1, 0), b3, voffB); PG8_STAGE(PG8_SB(1, 1), b3 + hstep, voffB); PG8_STAGE(PG8_SA(1, 0), a3, voffA);
            PG8_WAIT_V(8); PG8_WAIT_L(0); PG8_BAR; PG8_MMA(1, 0, At, B0); PG8_MMA(1, 1, At, B1); PG8_BAR; PG8_SCHED;
            } else {
            PG8_LDB(B0, 0, 0); PG8_SCHED; PG8_LDA(At, 0, 0); PG8_STAGE(PG8_SA(1, 1), a1 + hstep, voffA);
            PG8_WAIT_L(8); PG8_BAR; PG8_WAIT_L(0); PG8_MMA(0, 0, At, B0); PG8_BAR; PG8_SCHED;
            PG8_LDB(B1, 0, 1); PG8_STAGE(PG8_SB(0, 0), b2, voffB);
            PG8_BAR; PG8_WAIT_L(0); PG8_MMA(0, 1, At, B1); PG8_BAR;
            PG8_LDA(At, 0, 1); PG8_STAGE(PG8_SA(0, 0), a2, voffA);
            PG8_BAR; PG8_WAIT_L(0); PG8_MMA(1, 0, At, B0); PG8_BAR; PG8_SCHED;
            PG8_STAGE(PG8_SB(0, 1), b2 + hstep, voffB);
            PG8_WAIT_V(6); PG8_BAR; PG8_MMA(1, 1, At, B1); PG8_BAR;
            PG8_LDB(B0, 1, 0); PG8_SCHED; PG8_LDA(At, 1, 0); PG8_STAGE(PG8_SA(0, 1), a2 + hstep, voffA);
            PG8_WAIT_L(8); PG8_BAR; PG8_WAIT_L(0); PG8_MMA(0, 0, At, B0); PG8_BAR; PG8_SCHED;
            PG8_LDB(B1, 1, 1); PG8_STAGE(PG8_SB(1, 0), b3, voffB);
            PG8_BAR; PG8_WAIT_L(0); PG8_MMA(0, 1, At, B1); PG8_BAR;
            PG8_LDA(At, 1, 1); PG8_STAGE(PG8_SA(1, 0), a3, voffA);
            PG8_BAR; PG8_WAIT_L(0); PG8_MMA(1, 0, At, B0); PG8_BAR; PG8_SCHED;
            PG8_STAGE(PG8_SB(1, 1), b3 + hstep, voffB);
            PG8_WAIT_V(6); PG8_BAR; PG8_MMA(1, 1, At, B1); PG8_BAR;
            }
        }
        if constexpr (ALIGN_EPI) { if (wr == 0) PG8_BAR; }
        if constexpr (!Epi::AFTER_DRAIN) { E(acc, cur, wr, wc, fr, fq); S.done(cur); }
        if (!has_next) break;
#pragma unroll
        for (int a = 0; a < 2; ++a)
#pragma unroll
            for (int b = 0; b < 2; ++b)
#pragma unroll
                for (int m = 0; m < 4; ++m)
#pragma unroll
                    for (int n = 0; n < 2; ++n) acc[a][b][m][n] = (f32x4){0.f, 0.f, 0.f, 0.f};
        cur = nxt; cA = nA; cB = nB; ++ui;
        if constexpr (ALIGN_EPI) { if (wr == 1) PG8_BAR; }
    }
    PG8_WAIT_V(0);
    if constexpr (!ALIGN_EPI) { if (wr == 0) PG8_BAR; }
    PG8_BAR;
    if constexpr (Epi::AFTER_DRAIN) { E.fused(acc, cur, wr, wc, fr, fq, lds, wid, lane); S.done(cur); }
#undef PG8_SA
#undef PG8_SB
#undef PG8_STAGE
#undef PG8_LDA
#undef PG8_LDB
#undef PG8_MMA
#undef PG8_WAIT_V
#undef PG8_WAIT_L
#undef PG8_BAR
#undef PG8_SCHED
}
template <class BRow, class Epi>
__device__ __forceinline__ void gemm_small_unit(PG8_LAS unsigned char* lds, const bf16_t* A, int lda, const bf16_t* Bt, int ldb, int k0, int nkt, const BRow& brow, const Epi& E) {
    const int tid = threadIdx.x, wid = __builtin_amdgcn_readfirstlane(tid >> 6), lane = tid & 63, fr = lane & 15, fq = lane >> 4;
    constexpr int SLOT = 24576;
    const char* sA0; const char* sA1; const char* sB;
    { int R, C; stage_rc(tid * 16, R, C); sA0 = (const char*)(A + (size_t)R * lda + k0 + C); sB = (const char*)(Bt + (size_t)brow(R) * ldb + k0 + C);
      stage_rc(tid * 16 + 8192, R, C); sA1 = (const char*)(A + (size_t)R * lda + k0 + C); }
    const unsigned ldsw = (unsigned)wid * 1024u;
    const int foff = lds_byte(fr, fq * 8);
#define SM_STAGE(t) do { const int _b = ((t) % 5) * SLOT; const size_t _ko = (size_t)(t) * 128; \
        __builtin_amdgcn_global_load_lds((const unsigned*)(sA0 + _ko), (PG8_LAS unsigned*)(lds + _b + ldsw), 16, 0, 0); \
        __builtin_amdgcn_global_load_lds((const unsigned*)(sA1 + _ko), (PG8_LAS unsigned*)(lds + _b + 8192 + ldsw), 16, 0, 0); \
        __builtin_amdgcn_global_load_lds((const unsigned*)(sB + _ko), (PG8_LAS unsigned*)(lds + _b + 16384 + ldsw), 16, 0, 0); } while (0)
    f32x4 acc[4];
#pragma unroll
    for (int n = 0; n < 4; ++n) acc[n] = (f32x4){0.f, 0.f, 0.f, 0.f};
    asm volatile("s_waitcnt vmcnt(0)" ::: "memory");
    SM_STAGE(0); SM_STAGE(1); SM_STAGE(2); SM_STAGE(3);
    for (int t = 0; t < nkt; ++t) {
        const int rem = nkt - 1 - t;
        if (rem >= 3) asm volatile("s_waitcnt vmcnt(9)" ::: "memory"); else if (rem == 2) asm volatile("s_waitcnt vmcnt(6)" ::: "memory"); else if (rem == 1) asm volatile("s_waitcnt vmcnt(3)" ::: "memory"); else asm volatile("s_waitcnt vmcnt(0)" ::: "memory");
        asm volatile("s_waitcnt lgkmcnt(0)" ::: "memory");
        __builtin_amdgcn_s_barrier();
        asm volatile("" ::: "memory");
        if (t + 4 < nkt) SM_STAGE(t + 4);
        const int b = (t % 5) * SLOT;
        bf16x8 af[2], bf[4][2];
#pragma unroll
        for (int k = 0; k < 2; ++k) af[k] = *(const PG8_LAS bf16x8*)(lds + b + foff + wid * 2048 + k * 1024);
#pragma unroll
        for (int n = 0; n < 4; ++n)
#pragma unroll
            for (int k = 0; k < 2; ++k) bf[n][k] = *(const PG8_LAS bf16x8*)(lds + b + 16384 + foff + n * 2048 + k * 1024);
#pragma unroll
        for (int n = 0; n < 4; ++n)
#pragma unroll
            for (int k = 0; k < 2; ++k) acc[n] = __builtin_amdgcn_mfma_f32_16x16x32_bf16(bf[n][k], af[k], acc[n], 0, 0, 0);
    }
    E(acc, wid * 16 + fr, fq);
    asm volatile("s_waitcnt lgkmcnt(0)" ::: "memory");
    __builtin_amdgcn_s_barrier();
    asm volatile("" ::: "memory");
#undef SM_STAGE
}
struct BRowLin { int r0; __device__ __forceinline__ int operator()(int R) const { return r0 + R; } };
struct BRowGU { int j, q; __device__ __forceinline__ int operator()(int R) const { return 256 * j + 32 * q + (R & 31) + ((R >> 5) << 7); } };
struct SEpiIn {
    bf16_t* P; float* ZF; int c0;
    __device__ __forceinline__ void operator()(const f32x4 (&acc)[4], int row, int fq) const {
        const int typ = c0 >> 10;
#pragma unroll
        for (int n = 0; n < 4; ++n) { const int c = c0 + 16 * n + 4 * fq; f32x4 v = acc[n];
            if (typ == 3) { *(f32x4*)(ZF + (size_t)row * 1024 + (c - 3072)) = v; continue; }
            if (typ <= 1) { const f32x2 a = gelu_pk((f32x2){v[0], v[1]}), b = gelu_pk((f32x2){v[2], v[3]}); v = (f32x4){a.x, a.y, b.x, b.y}; }
            else if (typ != 4) v = (f32x4){silu_f(v[0]), silu_f(v[1]), silu_f(v[2]), silu_f(v[3])};
            typedef unsigned u32x2 __attribute__((ext_vector_type(2))); u32x2 w; w.x = cvt_pk_bf16(v[0], v[1]); w.y = cvt_pk_bf16(v[2], v[3]);
            *(u32x2*)(P + (size_t)row * 6144 + c) = w; }
    }
};
struct SEpiF32 { float* O; int ldc; int c0;
    __device__ __forceinline__ void operator()(const f32x4 (&acc)[4], int row, int fq) const {
#pragma unroll
        for (int n = 0; n < 4; ++n) *(f32x4*)(O + (size_t)row * ldc + c0 + 16 * n + 4 * fq) = acc[n]; }
};
struct SEpiF32WT { float* O; int ldc; int c0;
    __device__ __forceinline__ void operator()(const f32x4 (&acc)[4], int row, int fq) const {
        const __amdgpu_buffer_rsrc_t r = __builtin_amdgcn_make_buffer_rsrc((void*)O, (short)0, 0x7fffffff, 0x00020000);
#pragma unroll
        for (int n = 0; n < 4; ++n) __builtin_amdgcn_raw_buffer_store_b128(__builtin_bit_cast(u32x4, acc[n]), r, (unsigned)(((size_t)row * ldc + c0 + 16 * n + 4 * fq) * 4), 0, 16); }
};
struct SEpiGU { bf16_t* O; int ldc; int c0;
    __device__ __forceinline__ void operator()(const f32x4 (&acc)[4], int row, int fq) const {
#pragma unroll
        for (int n = 0; n < 2; ++n) { const f32x4 g = acc[n], u = acc[n + 2];
            typedef unsigned u32x2 __attribute__((ext_vector_type(2))); u32x2 w; w.x = cvt_pk_bf16(silu_f(g[0]) * u[0], silu_f(g[1]) * u[1]); w.y = cvt_pk_bf16(silu_f(g[2]) * u[2], silu_f(g[3]) * u[3]);
            *(u32x2*)(O + (size_t)row * ldc + c0 + 16 * n + 4 * fq) = w; }
    }
};
}
constexpr int NWAVES = 8;
#ifndef MK_MULTI
#define MK_MULTI 0
#endif
#ifndef DUP_CONV
#define DUP_CONV 0
#endif
#ifndef DUP_NORM
#define DUP_NORM 0
#endif
#ifndef DUP_MIX
#define DUP_MIX 0
#endif
#ifndef DUP_GEMM
#define DUP_GEMM 0
#endif
constexpr int DM = 2048, MP = 8192, MS = 128, MREAL = MP + MS, MT = 8448;
constexpr int INW = 6144, DFF = 5632, AW = 1024, DEPTH = 4, SEQ = 2048, NB = 4;
constexpr float EPS = 1e-6f;
constexpr size_t MiB = 1u << 20;
constexpr size_t WS_CTL = 0, CTL_ZERO_BYTES = 1 * MiB;
constexpr size_t WS_LB = 1 * MiB;
constexpr size_t WS_WIN = 2 * MiB, WS_WOUT = 98 * MiB, WS_WGU = 130 * MiB, WS_WDN = 306 * MiB;
constexpr size_t WS_X = 394 * MiB, WS_H = 460 * MiB, WS_PROJ = 493 * MiB, WS_ZF = 592 * MiB, WS_MIXIN = 625 * MiB, WS_MIX = 658 * MiB, WS_ACT = 724 * MiB, WS_MIXS = 816 * MiB, WS_HQF = 820 * MiB, WS_HKET = 836 * MiB, WS_HIT = 852 * MiB, WS_HOI = 868 * MiB, WS_HDL = 884 * MiB, WS_END = 888 * MiB;
static_assert(WS_WIN + (size_t)DEPTH * INW * DM * 2 <= WS_WOUT && WS_WOUT + (size_t)DEPTH * DM * DM * 2 <= WS_WGU && WS_WGU + (size_t)DEPTH * 2 * DFF * DM * 2 <= WS_WDN && WS_WDN + (size_t)DEPTH * DM * DFF * 2 <= WS_X, "ws map (weights)");
static_assert(WS_X + (size_t)MT * DM * 4 <= WS_H && WS_H + (size_t)MT * DM * 2 <= WS_PROJ && WS_PROJ + (size_t)MT * INW * 2 <= WS_ZF && WS_ZF + (size_t)MT * AW * 4 <= WS_MIXIN && WS_MIXIN + (size_t)MT * DM * 2 <= WS_MIX && WS_MIX + (size_t)MT * DM * 4 <= WS_ACT && WS_ACT + (size_t)MT * DFF * 2 <= WS_MIXS, "ws map (activations)");
#ifndef FUSE_NORM
#define FUSE_NORM 1
#endif
constexpr int CW_BAR = 4096, CW_CNT0 = 32768, CW_FLAG0 = 131072;
constexpr size_t OUT_Y = 0, OUT_SP = 17039360, OUT_SS = 19136512, OUT_VP = 86245376, OUT_VS = 88342528, OUT_TOTAL = 88866816;
constexpr int RING_BYTES = 131072, LDSCTL_OFF = RING_BYTES, MISC_OFF = LDSCTL_OFF + 320, XTRA_OFF = LDSCTL_OFF + 1024, LDS_BYTES = 147456;

typedef unsigned short bf16;
typedef unsigned v4u __attribute__((ext_vector_type(4)));
typedef unsigned v2u __attribute__((ext_vector_type(2)));
typedef float f32x4 __attribute__((ext_vector_type(4)));
#define GAS __attribute__((address_space(1)))
#define LAS __attribute__((address_space(3)))
typedef GAS unsigned gu32;
#define RLX_AGENT __ATOMIC_RELAXED, __HIP_MEMORY_SCOPE_AGENT
#define LDS_WAIT() asm volatile("s_waitcnt lgkmcnt(0)" ::: "memory")
typedef float f32x2_t __attribute__((ext_vector_type(2))); typedef __bf16 bf16x2_t __attribute__((ext_vector_type(2)));
__device__ __forceinline__ unsigned pk2(float lo, float hi) { f32x2_t v = {lo, hi}; bf16x2_t b = __builtin_convertvector(v, bf16x2_t); return __builtin_bit_cast(unsigned, b); }
__device__ __forceinline__ float bf2f(unsigned short b) { return __uint_as_float((unsigned)b << 16); }
__device__ __forceinline__ float bflo(unsigned w) { return __uint_as_float(w << 16); }
__device__ __forceinline__ float bfhi(unsigned w) { return __uint_as_float(w & 0xffff0000u); }
__device__ __forceinline__ float wave_sum(float v) {
#pragma unroll
    for (int o = 1; o < 64; o <<= 1) v += __shfl_xor(v, o);
    return v;
}
__device__ __forceinline__ float sigmoid_f(float x) { return 1.0f / (1.0f + __expf(-x)); }
#define XB_TMO      128
#define XB_XCNT(j)  (256  + 64 * (j))
#define XB_XSUB(j)  (1280 + 64 * (j))
#define XB_XGEN(j)  (2304 + 64 * (j))
#define XB_TOP      3328
#define XB_TOPGEN   3392
#define XCD_BAR_WORDS 3456
#define XB_SPIN_CAP (1u << 18)

__device__ __forceinline__ unsigned xb_ld(unsigned* p)              { return __hip_atomic_load(p, __ATOMIC_RELAXED, __HIP_MEMORY_SCOPE_AGENT); }
__device__ __forceinline__ unsigned xb_add(unsigned* p, unsigned v) { return __hip_atomic_fetch_add(p, v, __ATOMIC_RELAXED, __HIP_MEMORY_SCOPE_AGENT); }
__device__ __forceinline__ unsigned xb_xcc_id() { return (unsigned)__builtin_amdgcn_s_getreg((3 << 11) | 20) & 0xFu; }
#define XB_SPIN(cond, bar) do { unsigned _sp = 0; while (cond) { __builtin_amdgcn_s_sleep(1); \
    if ((++_sp & 255u) == 0u) { if (xb_ld(&(bar)[XB_TMO])) break; if (_sp > XB_SPIN_CAP) { atomicAdd(&(bar)[XB_TMO], 1u); break; } } } } while (0)

struct XcdBarrier {
    unsigned* bar; unsigned x;
    volatile LAS unsigned* st;
};

__device__ __forceinline__ XcdBarrier xcd_barrier_post(unsigned* bar, volatile LAS unsigned* st) {
    XcdBarrier b; b.bar = bar; b.x = xb_xcc_id(); b.st = st;
    if (threadIdx.x == 0) (void)xb_add(&bar[XB_XCNT(b.x)], 1u);
    return b;
}
__device__ __forceinline__ void xcd_barrier_complete(unsigned* bar, unsigned x, unsigned& nloc, unsigned& nx) {
    const unsigned G = gridDim.x * gridDim.y * gridDim.z;
    unsigned sum, cnt, mine, sp = 0u;
    for (;;) {
        sum = 0u; cnt = 0u; mine = 0u;
#pragma unroll
        for (unsigned j = 0; j < 16; ++j) { const unsigned c = xb_ld(&bar[XB_XCNT(j)]); sum += c; cnt += (c > 0u) ? 1u : 0u; mine = (j == x) ? c : mine; }
        if (sum == G) break;
        __builtin_amdgcn_s_sleep(1);
        if ((++sp & 255u) == 0u) { if (xb_ld(&bar[XB_TMO])) break; if (sp > XB_SPIN_CAP) { atomicAdd(&bar[XB_TMO], 1u); break; } }
    }
    nloc = mine > 0u ? mine : 1u; nx = cnt > 0u ? cnt : 1u;
}

__device__ __forceinline__ void xcd_barrier(const XcdBarrier& b) {
    asm volatile("s_waitcnt vmcnt(0)" ::: "memory");
    __syncthreads();
    if (threadIdx.x == 0) {
        unsigned* bar = b.bar;
        __builtin_amdgcn_s_waitcnt(0);
        unsigned nloc = b.st[0], nx = b.st[1];
        if (nloc == 0u) { xcd_barrier_complete(bar, b.x, nloc, nx); b.st[0] = nloc; b.st[1] = nx; }
        const unsigned old = xb_add(&bar[XB_XSUB(b.x)], 1u);
        const unsigned gen = old / nloc;
        if (old + 1u == (gen + 1u) * nloc) {
            __builtin_amdgcn_fence(__ATOMIC_RELEASE, "agent");
            asm volatile("s_waitcnt vmcnt(0)" ::: "memory");
            const unsigned og = xb_add(&bar[XB_TOP], 1u);
            const unsigned tg = og / nx;
            if (og + 1u == (tg + 1u) * nx) xb_add(&bar[XB_TOPGEN], 1u);
            else XB_SPIN(xb_ld(&bar[XB_TOPGEN]) == tg, bar);
            __builtin_amdgcn_fence(__ATOMIC_ACQUIRE, "agent");
            xb_add(&bar[XB_XGEN(b.x)], 1u);
            asm volatile("s_waitcnt vmcnt(0)" ::: "memory");
        } else {
            XB_SPIN(xb_ld(&bar[XB_XGEN(b.x)]) == gen, bar);
            __builtin_amdgcn_fence(__ATOMIC_ACQUIRE, "agent");
            asm volatile("s_waitcnt vmcnt(0)" ::: "memory");
        }
    }
    __syncthreads();
}
__device__ __forceinline__ void p0_transpose_item(const float* W, int K, int N, bf16* WT, int mode, LAS float* scr, int item, int lane) {
    const int nblk = N / 32, kb = item / nblk, nb = item % nblk, k0 = 64 * kb, n0 = 32 * nb;
    const int r0 = (mode == 0) ? n0 : (256 * (n0 >> 7) + (n0 & 127) + (mode == 2 ? 128 : 0));
    f32x4 x[8];
#pragma unroll
    for (int i = 0; i < 8; ++i) x[i] = __builtin_nontemporal_load((const f32x4*)(W + (size_t)(k0 + (lane >> 3) + 8 * i) * N + n0 + 4 * (lane & 7)));
#pragma unroll
    for (int i = 0; i < 8; ++i) { LAS float* d = scr + ((lane >> 3) + 8 * i) * 33 + 4 * (lane & 7); d[0] = x[i].x; d[1] = x[i].y; d[2] = x[i].z; d[3] = x[i].w; }
    LDS_WAIT(); asm volatile("" ::: "memory");
    const int c = lane & 7;
#pragma unroll
    for (int j = 0; j < 4; ++j) { const int n = (lane >> 3) + 8 * j; const LAS float* s = scr + (8 * c) * 33 + n;
        v4u o; o.x = pk2(s[0 * 33], s[1 * 33]); o.y = pk2(s[2 * 33], s[3 * 33]); o.z = pk2(s[4 * 33], s[5 * 33]); o.w = pk2(s[6 * 33], s[7 * 33]);
        *(GAS v4u*)(WT + (size_t)(r0 + n) * K + k0 + 8 * c) = o; }
    LDS_WAIT(); asm volatile("" ::: "memory");
}
struct WPtrs { const float* w_in; const float* w_out; const float* w_gate; const float* w_up; const float* w_down; bf16* Win_t; bf16* Wout_t; bf16* Wgu_t; bf16* Wdn_t; };
__device__ __forceinline__ void convert_layer(const WPtrs& P, int l, int wv, int NW, LAS float* scr, int lane, int part = 0) {
    constexpr int I_IN = (DM / 64) * (INW / 32), I_OUT = (DM / 64) * (DM / 32), I_G = (DM / 64) * (DFF / 32), I_D = (DFF / 64) * (DM / 32), I_L = I_IN + I_OUT + 2 * I_G + I_D;
    const int lo = (part == 10) ? I_IN : (part == 8) ? I_IN + I_OUT : (part == 9) ? I_IN + I_OUT + I_G : (part == 6) ? I_L - I_D : 0;
    const int hi = (part == 11) ? I_IN : (part == 1 || part == 10) ? I_IN + I_OUT : (part == 8) ? I_IN + I_OUT + I_G : (part == 9) ? I_IN + I_OUT + 2 * I_G : I_L;
    for (int it = lo + wv; it < hi; it += NW) {
        int r = it;
        if (r < I_IN) { p0_transpose_item(P.w_in + (size_t)l * DM * INW, DM, INW, P.Win_t + (size_t)l * INW * DM, 0, scr, r, lane); continue; } r -= I_IN;
        if (r < I_OUT) { p0_transpose_item(P.w_out + (size_t)l * DM * DM, DM, DM, P.Wout_t + (size_t)l * DM * DM, 0, scr, r, lane); continue; } r -= I_OUT;
        if (r < I_G) { p0_transpose_item(P.w_gate + (size_t)l * DM * DFF, DM, DFF, P.Wgu_t + (size_t)l * 2 * DFF * DM, 1, scr, r, lane); continue; } r -= I_G;
        if (r < I_G) { p0_transpose_item(P.w_up + (size_t)l * DM * DFF, DM, DFF, P.Wgu_t + (size_t)l * 2 * DFF * DM, 2, scr, r, lane); continue; } r -= I_G;
        p0_transpose_item(P.w_down + (size_t)l * DFF * DM, DFF, DM, P.Wdn_t + (size_t)l * DM * DFF, 0, scr, r, lane);
    }
}
__device__ __forceinline__ void norm_in_row(const float* xrow, const float* g, bf16* hrow, int lane) {
    f32x4 v[8]; float ss = 0.f;
#pragma unroll
    for (int j = 0; j < 8; ++j) { v[j] = ((const f32x4*)xrow)[lane + 64 * j]; ss += (v[j].x * v[j].x + v[j].y * v[j].y) + (v[j].z * v[j].z + v[j].w * v[j].w); }
    const float rstd = 1.0f / sqrtf(wave_sum(ss) * (1.0f / DM) + EPS);
#pragma unroll
    for (int j = 0; j < 8; ++j) { const f32x4 gv = ((const f32x4*)g)[lane + 64 * j]; v2u o; o.x = pk2(v[j].x * rstd * gv.x, v[j].y * rstd * gv.y); o.y = pk2(v[j].z * rstd * gv.z, v[j].w * rstd * gv.w);
        ((v2u*)hrow)[lane + 64 * j] = o; }
}
template <bool BF> __device__ __forceinline__ void ld8(const void* row, int lane, int j, float (&o)[8]) {
    if (BF) { const v4u a = ((const v4u*)row)[lane + 64 * j]; o[0] = bflo(a.x); o[1] = bfhi(a.x); o[2] = bflo(a.y); o[3] = bfhi(a.y); o[4] = bflo(a.z); o[5] = bfhi(a.z); o[6] = bflo(a.w); o[7] = bfhi(a.w); }
    else { const f32x4 a = ((const f32x4*)row)[2 * (lane + 64 * j)], c = ((const f32x4*)row)[2 * (lane + 64 * j) + 1]; o[0] = a.x; o[1] = a.y; o[2] = a.z; o[3] = a.w; o[4] = c.x; o[5] = c.y; o[6] = c.z; o[7] = c.w; }
}
__device__ __forceinline__ void ld8_sc1(__amdgpu_buffer_rsrc_t r, size_t row_byte_off, int lane, int j, float (&o)[8]) {
    const v4u a = __builtin_amdgcn_raw_buffer_load_b128(r, (unsigned)(row_byte_off + (size_t)(lane + 64 * j) * 16), 0, 16);
    o[0] = bflo(a.x); o[1] = bfhi(a.x); o[2] = bflo(a.y); o[3] = bfhi(a.y); o[4] = bflo(a.z); o[5] = bfhi(a.z); o[6] = bflo(a.w); o[7] = bfhi(a.w);
}
template <bool XBF> __device__ __forceinline__ void norm_res_row2_sc1(__amdgpu_buffer_rsrc_t rmix, size_t m, const void* x0, size_t xstride_bytes, const float* gpost, bf16* xb0, float* y0, const float* gpre, bf16* h0, int lane) {
    float v[2][4][8]; float ss[2] = {0.f, 0.f};
#pragma unroll
    for (int r = 0; r < 2; ++r)
#pragma unroll
        for (int j = 0; j < 4; ++j) { ld8_sc1(rmix, (m + r) * (size_t)DM * 2, lane, j, v[r][j]);
#pragma unroll
            for (int e = 0; e < 8; ++e) ss[r] += v[r][j][e] * v[r][j][e]; }
    float x[2][4][8];
#pragma unroll
    for (int r = 0; r < 2; ++r)
#pragma unroll
        for (int j = 0; j < 4; ++j) ld8<XBF>((const char*)x0 + r * xstride_bytes, lane, j, x[r][j]);
    const float rs0 = __builtin_amdgcn_rsqf(wave_sum(ss[0]) * (1.0f / DM) + EPS), rs1 = __builtin_amdgcn_rsqf(wave_sum(ss[1]) * (1.0f / DM) + EPS);
    float ss1[2] = {0.f, 0.f};
#pragma unroll
    for (int j = 0; j < 4; ++j) { float g[8]; ld8<false>(gpost, lane, j, g);
#pragma unroll
        for (int r = 0; r < 2; ++r) { const float rs = r ? rs1 : rs0;
#pragma unroll
            for (int e = 0; e < 8; ++e) { v[r][j][e] = x[r][j][e] + v[r][j][e] * rs * g[e]; ss1[r] += v[r][j][e] * v[r][j][e]; }
            if (xb0) ((v4u*)(xb0 + (size_t)r * DM))[lane + 64 * j] = (v4u){pk2(v[r][j][0], v[r][j][1]), pk2(v[r][j][2], v[r][j][3]), pk2(v[r][j][4], v[r][j][5]), pk2(v[r][j][6], v[r][j][7])};
            if (y0) { f32x4* yp = (f32x4*)(y0 + (size_t)r * DM); yp[2 * (lane + 64 * j)] = (f32x4){v[r][j][0], v[r][j][1], v[r][j][2], v[r][j][3]}; yp[2 * (lane + 64 * j) + 1] = (f32x4){v[r][j][4], v[r][j][5], v[r][j][6], v[r][j][7]}; } } }
    if (h0) {
        const float q0 = __builtin_amdgcn_rsqf(wave_sum(ss1[0]) * (1.0f / DM) + EPS), q1 = __builtin_amdgcn_rsqf(wave_sum(ss1[1]) * (1.0f / DM) + EPS);
#pragma unroll
        for (int j = 0; j < 4; ++j) { float g[8]; ld8<false>(gpre, lane, j, g);
#pragma unroll
            for (int r = 0; r < 2; ++r) { const float q = r ? q1 : q0;
                ((v4u*)(h0 + (size_t)r * DM))[lane + 64 * j] = (v4u){pk2(v[r][j][0] * q * g[0], v[r][j][1] * q * g[1]), pk2(v[r][j][2] * q * g[2], v[r][j][3] * q * g[3]), pk2(v[r][j][4] * q * g[4], v[r][j][5] * q * g[5]), pk2(v[r][j][6] * q * g[6], v[r][j][7] * q * g[7])}; } }
    }
}
template <bool XBF> __device__ __forceinline__ void norm_res_row_s(__amdgpu_buffer_rsrc_t rm, size_t row_off, int nslab, size_t slab_bytes, const void* xrow, const float* gpost, bf16* xb, float* yout, const float* gpre, bf16* hrow, int lane) {
    float v[4][8]; float ss = 0.f;
#pragma unroll
    for (int j = 0; j < 4; ++j) {
#pragma unroll
        for (int e = 0; e < 8; ++e) v[j][e] = 0.f;
        _Pragma("unroll 1") for (int sl = 0; sl < nslab; ++sl) { const unsigned o = (unsigned)(row_off + sl * slab_bytes + (size_t)(lane + 64 * j) * 32);
            const v4u a = __builtin_amdgcn_raw_buffer_load_b128(rm, o, 0, 16), c = __builtin_amdgcn_raw_buffer_load_b128(rm, o + 16, 0, 16);
            v[j][0] += __uint_as_float(a.x); v[j][1] += __uint_as_float(a.y); v[j][2] += __uint_as_float(a.z); v[j][3] += __uint_as_float(a.w);
            v[j][4] += __uint_as_float(c.x); v[j][5] += __uint_as_float(c.y); v[j][6] += __uint_as_float(c.z); v[j][7] += __uint_as_float(c.w); }
#pragma unroll
        for (int e = 0; e < 8; ++e) ss += v[j][e] * v[j][e]; }
    const float rstd = __builtin_amdgcn_rsqf(wave_sum(ss) * (1.0f / DM) + EPS);
    float ss1 = 0.f;
#pragma unroll
    for (int j = 0; j < 4; ++j) { float g[8], x[8]; ld8<false>(gpost, lane, j, g); ld8<XBF>(xrow, lane, j, x);
#pragma unroll
        for (int e = 0; e < 8; ++e) { v[j][e] = x[e] + v[j][e] * rstd * g[e]; ss1 += v[j][e] * v[j][e]; }
        if (xb) ((v4u*)xb)[lane + 64 * j] = (v4u){pk2(v[j][0], v[j][1]), pk2(v[j][2], v[j][3]), pk2(v[j][4], v[j][5]), pk2(v[j][6], v[j][7])};
        if (yout) { ((f32x4*)yout)[2 * (lane + 64 * j)] = (f32x4){v[j][0], v[j][1], v[j][2], v[j][3]}; ((f32x4*)yout)[2 * (lane + 64 * j) + 1] = (f32x4){v[j][4], v[j][5], v[j][6], v[j][7]}; } }
    if (hrow) {
        const float rstd1 = __builtin_amdgcn_rsqf(wave_sum(ss1) * (1.0f / DM) + EPS);
#pragma unroll
        for (int j = 0; j < 4; ++j) { float g[8]; ld8<false>(gpre, lane, j, g);
            ((v4u*)hrow)[lane + 64 * j] = (v4u){pk2(v[j][0] * rstd1 * g[0], v[j][1] * rstd1 * g[1]), pk2(v[j][2] * rstd1 * g[2], v[j][3] * rstd1 * g[3]), pk2(v[j][4] * rstd1 * g[4], v[j][5] * rstd1 * g[5]), pk2(v[j][6] * rstd1 * g[6], v[j][7] * rstd1 * g[7])}; }
    }
}
__device__ __forceinline__ void sample_count(unsigned* cnt, int n, int tid) {
    asm volatile("s_waitcnt vmcnt(0)" ::: "memory"); __syncthreads();
    if (tid == 0 && n > 0) __hip_atomic_fetch_add(cnt, (unsigned)n, __ATOMIC_RELAXED, __HIP_MEMORY_SCOPE_AGENT);
}
__device__ __forceinline__ void sample_wait(unsigned* cnt, unsigned want, int tid) {
    if (tid == 0) { unsigned sp = 0u; while (__hip_atomic_load(cnt, __ATOMIC_RELAXED, __HIP_MEMORY_SCOPE_AGENT) < want) { __builtin_amdgcn_s_sleep(2); if (++sp > (1u << 17)) break; } }
    __syncthreads(); asm volatile("" ::: "memory");
}
__device__ __forceinline__ bool panel_wait(unsigned* cnt, int tid) {
    __syncthreads();
    if (tid == 0) { __hip_atomic_fetch_add(cnt, 1u, __ATOMIC_RELAXED, __HIP_MEMORY_SCOPE_AGENT);
        unsigned sp = 0u; while (__hip_atomic_load(cnt, __ATOMIC_RELAXED, __HIP_MEMORY_SCOPE_AGENT) < 8u) { __builtin_amdgcn_s_sleep(2); if (++sp > (1u << 17)) break; } }
    __syncthreads();
    asm volatile("" ::: "memory");
    return true;
}
template <bool MIXBF, bool XBF> __device__ __forceinline__ void norm_res_row(const void* mixrow, int nslab, size_t slab_stride, const void* xrow, const float* gpost, bf16* xb, float* yout, const float* gpre, bf16* hrow, int lane) {
    float v[4][8]; float ss = 0.f;
#pragma unroll
    for (int j = 0; j < 4; ++j) { ld8<MIXBF>(mixrow, lane, j, v[j]);
        if (!MIXBF) for (int sl = 1; sl < nslab; ++sl) { float p[8]; ld8<false>((const float*)mixrow + sl * slab_stride, lane, j, p);
#pragma unroll
            for (int e = 0; e < 8; ++e) v[j][e] += p[e]; }
#pragma unroll
        for (int e = 0; e < 8; ++e) ss += v[j][e] * v[j][e]; }
    const float rstd = __builtin_amdgcn_rsqf(wave_sum(ss) * (1.0f / DM) + EPS);
    float ss1 = 0.f;
#pragma unroll
    for (int j = 0; j < 4; ++j) { float g[8], x[8]; ld8<false>(gpost, lane, j, g); ld8<XBF>(xrow, lane, j, x);
#pragma unroll
        for (int e = 0; e < 8; ++e) { v[j][e] = x[e] + v[j][e] * rstd * g[e]; ss1 += v[j][e] * v[j][e]; }
        if (xb) ((v4u*)xb)[lane + 64 * j] = (v4u){pk2(v[j][0], v[j][1]), pk2(v[j][2], v[j][3]), pk2(v[j][4], v[j][5]), pk2(v[j][6], v[j][7])};
        if (yout) { ((f32x4*)yout)[2 * (lane + 64 * j)] = (f32x4){v[j][0], v[j][1], v[j][2], v[j][3]}; ((f32x4*)yout)[2 * (lane + 64 * j) + 1] = (f32x4){v[j][4], v[j][5], v[j][6], v[j][7]}; } }
    if (hrow) {
        const float rstd1 = __builtin_amdgcn_rsqf(wave_sum(ss1) * (1.0f / DM) + EPS);
#pragma unroll
        for (int j = 0; j < 4; ++j) { float g[8]; ld8<false>(gpre, lane, j, g);
            ((v4u*)hrow)[lane + 64 * j] = (v4u){pk2(v[j][0] * rstd1 * g[0], v[j][1] * rstd1 * g[1]), pk2(v[j][2] * rstd1 * g[2], v[j][3] * rstd1 * g[3]), pk2(v[j][4] * rstd1 * g[4], v[j][5] * rstd1 * g[5]), pk2(v[j][6] * rstd1 * g[6], v[j][7] * rstd1 * g[7])}; }
    }
}

struct MixArgs {
    int l;
    bf16* PROJ; float* ZF; bf16* MIXIN; const float* LB;
    const float* ln_g; const float* ln_b; const float* sw; const float* sb; const float* gout;
    const float* state_in;
    float* out;
};
__device__ __forceinline__ void hgrn_prompt_item(const MixArgs& A, int b, int h, LAS unsigned char* lds, int tid) {
    LAS float* F = (LAS float*)lds; LAS float* KK = F + 2048; LAS float* Q = KK + 2048; LAS float* I = Q + 2048; LAS float* OP = I + 2048;
    const int v = tid & 127, kg = tid >> 7;
    float S[32];
#pragma unroll
    for (int j = 0; j < 32; ++j) S[j] = 0.f;
    const float lbv = A.LB[A.l * 1024 + h * 128 + (tid & 127)];
    for (int t0 = 0; t0 < SEQ; t0 += 16) {
        const int m0 = b * SEQ + t0;
#pragma unroll
        for (int i = 0; i < 4; ++i) { const int t = (tid >> 7) + 4 * i, k = tid & 127; const size_t row = (size_t)(m0 + t);
            const float z = A.ZF[row * 1024 + h * 128 + k]; const float sg = sigmoid_f(z);
            F[t * 128 + k] = lbv + (1.0f - lbv) * sg; KK[t * 128 + k] = (1.0f - lbv) * (1.0f - sg);
            Q[t * 128 + k] = bf2f(A.PROJ[row * INW + 2048 + h * 128 + k]); I[t * 128 + k] = bf2f(A.PROJ[row * INW + 4096 + h * 128 + k]); }
        __syncthreads();
#pragma unroll 1
        for (int t = 0; t < 16; ++t) {
            const float iv = I[t * 128 + v]; float op = 0.f;
#pragma unroll
            for (int jj = 0; jj < 8; ++jj) {
                const f32x4 f4 = *(LAS f32x4*)(F + t * 128 + 32 * kg + 4 * jj), k4 = *(LAS f32x4*)(KK + t * 128 + 32 * kg + 4 * jj), q4 = *(LAS f32x4*)(Q + t * 128 + 32 * kg + 4 * jj);
                S[4 * jj + 0] = f4.x * S[4 * jj + 0] + k4.x * iv; op += S[4 * jj + 0] * q4.x;
                S[4 * jj + 1] = f4.y * S[4 * jj + 1] + k4.y * iv; op += S[4 * jj + 1] * q4.y;
                S[4 * jj + 2] = f4.z * S[4 * jj + 2] + k4.z * iv; op += S[4 * jj + 2] * q4.z;
                S[4 * jj + 3] = f4.w * S[4 * jj + 3] + k4.w * iv; op += S[4 * jj + 3] * q4.w;
            }
            OP[(t * 4 + kg) * 128 + v] = op;
        }
        __syncthreads();
        {   const int t = tid >> 5, vq = tid & 31; const size_t row = (size_t)(m0 + t);
            f32x4 o = *(LAS f32x4*)(OP + (t * 4 + 0) * 128 + 4 * vq);
#pragma unroll
            for (int g = 1; g < 4; ++g) { const f32x4 p = *(LAS f32x4*)(OP + (t * 4 + g) * 128 + 4 * vq); o.x += p.x; o.y += p.y; o.z += p.z; o.w += p.w; }
            float ss = (o.x * o.x + o.y * o.y) + (o.z * o.z + o.w * o.w);
#pragma unroll
            for (int d = 1; d < 32; d <<= 1) ss += __shfl_xor(ss, d);
            const float rstd = 1.0f / sqrtf(ss * (1.0f / 128.0f) + EPS);
            const f32x4 go = *(const f32x4*)(A.gout + h * 128 + 4 * vq);
            const v2u sg = *(const v2u*)(A.PROJ + row * INW + 5120 + h * 128 + 4 * vq);
            v2u w; w.x = pk2(o.x * rstd * go.x * bflo(sg.x), o.y * rstd * go.y * bfhi(sg.x)); w.y = pk2(o.z * rstd * go.z * bflo(sg.y), o.w * rstd * go.w * bfhi(sg.y));
            *(v2u*)(A.MIXIN + row * DM + 1024 + h * 128 + 4 * vq) = w; }
    }
    float* sp = A.out + OUT_SP + ((size_t)((A.l * NB + b) * 8 + h) * 128) * 128;
#pragma unroll
    for (int j = 0; j < 32; ++j) sp[(size_t)(32 * kg + j) * 128 + v] = S[j];
    __syncthreads();
}
__device__ __forceinline__ void hgrn_sample_item(const MixArgs& A, int b, int h, LAS unsigned char* lds, int tid) {
    LAS float* OPART = (LAS float*)lds;
    const int lane = tid & 63, w = tid >> 6, vq = lane & 31, par = lane >> 5;
    const size_t row = (size_t)(MP + b);
    const float* s0 = A.state_in + ((size_t)(b * 8 + h) * 128) * 128;
    float* s1 = A.out + OUT_SS + ((size_t)((A.l * MS + b) * 8 + h) * 128) * 128;
    const v2u ib = *(const v2u*)(A.PROJ + row * INW + 4096 + h * 128 + 4 * vq);
    const f32x4 i4 = (f32x4){bflo(ib.x), bfhi(ib.x), bflo(ib.y), bfhi(ib.y)};
    f32x4 o = (f32x4){0.f, 0.f, 0.f, 0.f};
    f32x4 sv[8];
#pragma unroll
    for (int it = 0; it < 8; ++it) { const int k = 16 * w + 2 * it + par; sv[it] = *(const f32x4*)(s0 + (size_t)k * 128 + 4 * vq); }
#pragma unroll
    for (int it = 0; it < 8; ++it) { const int k = 16 * w + 2 * it + par;
        const float z = A.ZF[row * 1024 + h * 128 + k]; const float lbv = A.LB[A.l * 1024 + h * 128 + k]; const float sg = sigmoid_f(z);
        const float f = lbv + (1.0f - lbv) * sg, kk = (1.0f - lbv) * (1.0f - sg); const float q = bf2f(A.PROJ[row * INW + 2048 + h * 128 + k]);
        f32x4 sn; sn.x = f * sv[it].x + kk * i4.x; sn.y = f * sv[it].y + kk * i4.y; sn.z = f * sv[it].z + kk * i4.z; sn.w = f * sv[it].w + kk * i4.w;
        *(f32x4*)(s1 + (size_t)k * 128 + 4 * vq) = sn;
        o.x += sn.x * q; o.y += sn.y * q; o.z += sn.z * q; o.w += sn.w * q; }
    o.x += __shfl_xor(o.x, 32); o.y += __shfl_xor(o.y, 32); o.z += __shfl_xor(o.z, 32); o.w += __shfl_xor(o.w, 32);
    if (par == 0) *(LAS f32x4*)(OPART + w * 128 + 4 * vq) = o;
    __syncthreads();
    if (w == 0) {
        float o0 = 0.f, o1 = 0.f;
#pragma unroll
        for (int g = 0; g < 8; ++g) { o0 += OPART[g * 128 + 2 * lane]; o1 += OPART[g * 128 + 2 * lane + 1]; }
        const float rstd = 1.0f / sqrtf(wave_sum(o0 * o0 + o1 * o1) * (1.0f / 128.0f) + EPS);
        const unsigned sg = *(const unsigned*)(A.PROJ + row * INW + 5120 + h * 128 + 2 * lane);
        const float g0 = A.gout[h * 128 + 2 * lane], g1 = A.gout[h * 128 + 2 * lane + 1];
        *(unsigned*)(A.MIXIN + row * DM + 1024 + h * 128 + 2 * lane) = pk2(o0 * rstd * g0 * bflo(sg), o1 * rstd * g1 * bfhi(sg));
    }
    __syncthreads();
}
__device__ __forceinline__ void gmlp_prompt_item(const MixArgs& A, int b, int n, LAS unsigned char* lds, int tid) {
    LAS float* VL = (LAS float*)lds;
    LAS float* WT = VL + 16384;
    LAS float* MU = (LAS float*)(lds + XTRA_OFF);
    LAS float* RS = MU + 128;
    const int lane = tid & 63, w = tid >> 6;
    const int m0_ = b * SEQ + 128 * n;
    { const int m0 = m0_;
#pragma unroll 2
    for (int r = 0; r < 16; ++r) { const size_t row = (size_t)(m0 + 16 * w + r);
        const v4u a = *(const v4u*)(A.PROJ + row * INW + 1024 + 8 * lane), c = *(const v4u*)(A.PROJ + row * INW + 1024 + 512 + 8 * lane);
        float x[16] = {bflo(a.x), bfhi(a.x), bflo(a.y), bfhi(a.y), bflo(a.z), bfhi(a.z), bflo(a.w), bfhi(a.w), bflo(c.x), bfhi(c.x), bflo(c.y), bfhi(c.y), bflo(c.z), bfhi(c.z), bflo(c.w), bfhi(c.w)};
        float s = 0.f;
#pragma unroll
        for (int i = 0; i < 16; ++i) s += x[i];
        const float mu = wave_sum(s) * (1.0f / 1024.0f); float q = 0.f;
#pragma unroll
        for (int i = 0; i < 16; ++i) { const float d = x[i] - mu; q += d * d; }
        const float rs = 1.0f / sqrtf(wave_sum(q) * (1.0f / 1024.0f) + EPS);
        if (lane == 0) { MU[16 * w + r] = mu; RS[16 * w + r] = rs; } }
    }
    __syncthreads();
    const int d = tid & 127, tg = tid >> 7;
    for (int h = 0; h < 8; ++h) {
        int m0 = __builtin_amdgcn_readfirstlane(m0_); asm volatile("" : "+s"(m0));
        const float lg = A.ln_g[h * 128 + d], lbias = A.ln_b[h * 128 + d];
#pragma unroll 4
        for (int i = 0; i < 32; ++i) { const int s = tg + 4 * i; const size_t row = (size_t)(m0 + s);
            const float vn = (bf2f(A.PROJ[row * INW + 1024 + h * 128 + d]) - MU[s]) * RS[s] * lg + lbias;
            VL[s * 128 + d] = vn;
            if (n == 15) A.out[OUT_VP + ((size_t)((A.l * NB + b) * 128 + s)) * 1024 + h * 128 + d] = vn; }
#pragma unroll 4
        for (int i = 0; i < 32; ++i) { const int t = tg + 4 * i; const int s = d;
            const float wv = A.sw[((size_t)h * 128 + t) * 128 + s]; WT[s * 128 + t] = (s <= t) ? wv : 0.f; }
        __syncthreads();
        float acc[32];
#pragma unroll
        for (int j = 0; j < 32; ++j) acc[j] = 0.f;
        const int smax = 32 * tg + 32;
#pragma unroll 2
        for (int s = 0; s < smax; ++s) { const float vv = VL[s * 128 + d];
#pragma unroll
            for (int jj = 0; jj < 8; ++jj) { const f32x4 w4 = *(LAS f32x4*)(WT + s * 128 + 32 * tg + 4 * jj);
                acc[4 * jj + 0] += w4.x * vv; acc[4 * jj + 1] += w4.y * vv; acc[4 * jj + 2] += w4.z * vv; acc[4 * jj + 3] += w4.w * vv; } }
#pragma unroll
        for (int j = 0; j < 32; ++j) { const int t = 32 * tg + j; const size_t row = (size_t)(m0 + t);
            const float u = bf2f(A.PROJ[row * INW + h * 128 + d]); const float o = u * (acc[j] + A.sb[h * 128 + t]);
            A.MIXIN[row * DM + h * 128 + d] = (bf16)(pk2(o, 0.f) & 0xffffu);
            if ((j & 3) == 3) asm volatile("" ::: "memory"); }
        __syncthreads();
    }
}
__device__ __forceinline__ void gmlp_sample_row(const MixArgs& A, int b, int lane) {
    const size_t row = (size_t)(MP + b);
    const v4u a = *(const v4u*)(A.PROJ + row * INW + 1024 + 8 * lane), c = *(const v4u*)(A.PROJ + row * INW + 1024 + 512 + 8 * lane);
    float x[16] = {bflo(a.x), bfhi(a.x), bflo(a.y), bfhi(a.y), bflo(a.z), bfhi(a.z), bflo(a.w), bfhi(a.w), bflo(c.x), bfhi(c.x), bflo(c.y), bfhi(c.y), bflo(c.z), bfhi(c.z), bflo(c.w), bfhi(c.w)};
    float s = 0.f;
#pragma unroll
    for (int i = 0; i < 16; ++i) s += x[i];
    const float mu = wave_sum(s) * (1.0f / 1024.0f); float q = 0.f;
#pragma unroll
    for (int i = 0; i < 16; ++i) { const float dd = x[i] - mu; q += dd * dd; }
    const float rs = 1.0f / sqrtf(wave_sum(q) * (1.0f / 1024.0f) + EPS);
    float* vs = A.out + OUT_VS + (size_t)(A.l * MS + b) * 1024;
#pragma unroll
    for (int half = 0; half < 2; ++half) { const int c0 = 512 * half + 8 * lane; const int h = c0 >> 7;
        const float w00 = A.sw[(size_t)h * 128 * 128], b0 = A.sb[h * 128];
        const v4u uu = *(const v4u*)(A.PROJ + row * INW + c0);
        const float uf[8] = {bflo(uu.x), bfhi(uu.x), bflo(uu.y), bfhi(uu.y), bflo(uu.z), bfhi(uu.z), bflo(uu.w), bfhi(uu.w)};
        float vn[8], o[8];
#pragma unroll
        for (int i = 0; i < 8; ++i) { vn[i] = (x[8 * half + i] - mu) * rs * A.ln_g[c0 + i] + A.ln_b[c0 + i]; o[i] = uf[i] * (w00 * vn[i] + b0); }
        *(f32x4*)(vs + c0) = (f32x4){vn[0], vn[1], vn[2], vn[3]}; *(f32x4*)(vs + c0 + 4) = (f32x4){vn[4], vn[5], vn[6], vn[7]};
        v4u w; w.x = pk2(o[0], o[1]); w.y = pk2(o[2], o[3]); w.z = pk2(o[4], o[5]); w.w = pk2(o[6], o[7]);
        *(v4u*)(A.MIXIN + row * DM + c0) = w; }
}

typedef short bf16x8 __attribute__((ext_vector_type(8)));
#define cvtpk_s pk2
#ifndef PROBE_SKIP_QS
#define PROBE_SKIP_QS 0
#endif
#define MFMA16(a, b, c) __builtin_amdgcn_mfma_f32_16x16x32_bf16((a), (b), (c), 0, 0, 0)
struct HgArgs { int l; bf16* PROJ; float* ZF; const float* LB; bf16* QF; bf16* KET; bf16* ITG; bf16* OI; float* DL; bf16* MIXIN; const float* gout; float* out; unsigned* flags; };
#define HG_RSRC(p, bytes) __builtin_amdgcn_make_buffer_rsrc((void*)(p), (short)0, (int)(bytes), 0x00020000)
template <int N> __device__ __forceinline__ void wait_flags(unsigned* f) {
    for (unsigned sp = 0u;; ) { unsigned ok = 1u;
#pragma unroll
        for (int i = 0; i < N; ++i) ok &= (__hip_atomic_load(f + i * 16, __ATOMIC_RELAXED, __HIP_MEMORY_SCOPE_AGENT) != 0u) ? 1u : 0u;
        if (ok) break; __builtin_amdgcn_s_sleep(4); if (++sp > (1u << 17)) break; }
    asm volatile("" ::: "memory");
}
__device__ __forceinline__ void wait_flag(unsigned* f) { unsigned sp = 0u; while (__hip_atomic_load(f, __ATOMIC_RELAXED, __HIP_MEMORY_SCOPE_AGENT) == 0u) { __builtin_amdgcn_s_sleep(4); if (++sp > (1u << 17)) break; } asm volatile("" ::: "memory"); }
constexpr int HG_QD = 0, HG_KD = 8704, HG_IT = 17408, HG_AT = 27648, HG_SEG = 30208, HG_KT = 32256, HG_DLS = 42496;
struct PreRegs { f32x4 z0, z1; v4u q, i; };
constexpr int HG_ZL = 43008, HG_QL = 59392, HG_IL = 67584;
__device__ __forceinline__ void hgrn_pre_load(const HgArgs& A, int it, PreRegs& P, int tid) {
    const int bh = it >> 6, c = it & 63, b = bh >> 3, h = bh & 7, t = tid >> 4, kq = tid & 15; const size_t row = (size_t)(b * SEQ + 32 * c + t);
    const float* zp = A.ZF + row * 1024 + h * 128 + 8 * kq; P.z0 = *(const f32x4*)zp; P.z1 = *(const f32x4*)(zp + 4);
    P.q = *(const v4u*)(A.PROJ + row * INW + 2048 + h * 128 + 8 * kq); P.i = *(const v4u*)(A.PROJ + row * INW + 4096 + h * 128 + 8 * kq);
}
__device__ __forceinline__ void hgrn_pre_item(const HgArgs& A, int it, int prev, int nxt, PreRegs& P, LAS unsigned char* lds, int tid) {
    const __amdgpu_buffer_rsrc_t rQF = HG_RSRC(A.QF, 16 << 20), rKE = HG_RSRC(A.KET, 16 << 20), rIT = HG_RSRC(A.ITG, 16 << 20), rOI = HG_RSRC(A.OI, 16 << 20);
    const int bh = it >> 6, c = it & 63, b = bh >> 3, h = bh & 7;
    const int m0 = b * SEQ + 32 * c;
    LAS bf16* QD = (LAS bf16*)(lds + HG_QD); LAS bf16* KD = (LAS bf16*)(lds + HG_KD); LAS bf16* IT = (LAS bf16*)(lds + HG_IT); LAS bf16* AT = (LAS bf16*)(lds + HG_AT); LAS float* SEG = (LAS float*)(lds + HG_SEG);
    const int k = tid & 127, seg = tid >> 7, lane = tid & 63, w = tid >> 6, fr = lane & 15, fq = lane >> 4;
    {   const int t = tid >> 4, kq = tid & 15;
        *(LAS f32x4*)(lds + HG_ZL + (t * 128 + 8 * kq) * 4) = P.z0; *(LAS f32x4*)(lds + HG_ZL + (t * 128 + 8 * kq + 4) * 4) = P.z1;
        *(LAS v4u*)(lds + HG_QL + (t * 128 + 8 * kq) * 2) = P.q; *(LAS v4u*)(lds + HG_IL + (t * 128 + 8 * kq) * 2) = P.i; }
    if (nxt >= 0) hgrn_pre_load(A, nxt, P, tid);
    __syncthreads();
    float z[8], qv[8]; unsigned iv[8];
#pragma unroll
    for (int j = 0; j < 8; ++j) { const int tt = 8 * seg + j; z[j] = *(const LAS float*)(lds + HG_ZL + (tt * 128 + k) * 4);
        qv[j] = bf2f(*(const LAS unsigned short*)(lds + HG_QL + (tt * 128 + k) * 2)); iv[j] = *(const LAS unsigned short*)(lds + HG_IL + (tt * 128 + k) * 2); }
    const float lbv = A.LB[A.l * 1024 + h * 128 + k];
    float kk[8], cs[8]; float run = 0.f;
#pragma unroll
    for (int j = 0; j < 8; ++j) { const float sg = sigmoid_f(z[j]); const float f = lbv + (1.0f - lbv) * sg; kk[j] = (1.0f - lbv) * (1.0f - sg); run += fmaxf(__logf(f), -60.0f); cs[j] = run; }
    SEG[seg * 128 + k] = run;
    v4u ip; ip.x = iv[0] | (iv[1] << 16); ip.y = iv[2] | (iv[3] << 16); ip.z = iv[4] | (iv[5] << 16); ip.w = iv[6] | (iv[7] << 16);
    *(LAS v4u*)(IT + k * 40 + 8 * seg) = ip;
    __syncthreads();
    float off = 0.f, tot = 0.f;
#pragma unroll
    for (int s = 0; s < 4; ++s) { const float sv = SEG[s * 128 + k]; tot += sv; off += (s < seg) ? sv : 0.f; }
    float ke[8];
#pragma unroll
    for (int j = 0; j < 8; ++j) { const float bj = off + cs[j];
        const float qd = qv[j] * __expf(fmaxf(bj, -80.0f)), kd = kk[j] * __expf(fminf(-bj, 80.0f)); ke[j] = kk[j] * __expf(tot - bj);
        QD[(8 * seg + j) * 136 + k] = (bf16)(pk2(qd, 0.f) & 0xffffu); KD[(8 * seg + j) * 136 + k] = (bf16)(pk2(kd, 0.f) & 0xffffu); }
    { v4u kp; kp.x = pk2(ke[0], ke[1]); kp.y = pk2(ke[2], ke[3]); kp.z = pk2(ke[4], ke[5]); kp.w = pk2(ke[6], ke[7]);
      *(LAS v4u*)(lds + HG_KT + (k * 40 + 8 * seg) * 2) = kp; }
    if (seg == 0) *(LAS float*)(lds + HG_DLS + k * 4) = __expf(tot);
    __syncthreads();
    if (w < 3) {
        const int tt = (w > 0) ? 1 : 0, st = (w == 2) ? 1 : 0; f32x4 acc = (f32x4){0.f, 0.f, 0.f, 0.f};
#pragma unroll
        for (int kb = 0; kb < 4; ++kb) { const bf16x8 a = *(const LAS bf16x8*)(QD + (16 * tt + fr) * 136 + 32 * kb + 8 * fq), bq = *(const LAS bf16x8*)(KD + (16 * st + fr) * 136 + 32 * kb + 8 * fq); acc = MFMA16(a, bq, acc); }
#pragma unroll
        for (int r = 0; r < 4; ++r) { const int t = 16 * tt + 4 * fq + r, s = 16 * st + fr; AT[t * 40 + s] = (bf16)(pk2((s <= t) ? acc[r] : 0.f, 0.f) & 0xffffu); }
    } else if (w == 3) {
#pragma unroll
        for (int r = 0; r < 4; ++r) AT[(4 * fq + r) * 40 + 16 + fr] = (bf16)0;
    }
    v4u qfv;
    {
        const int tt = w >> 2, kb = w & 3;
        const v2u lo = *(const LAS v2u*)(QD + (16 * tt + fr) * 136 + 32 * kb + 4 * fq), hi = *(const LAS v2u*)(QD + (16 * tt + fr) * 136 + 32 * kb + 16 + 4 * fq);
        qfv = (v4u){lo.x, lo.y, hi.x, hi.y}; }
    __syncthreads();
    v4u oiv;
    {
        const bf16x8 a = *(const LAS bf16x8*)(IT + (16 * w + fr) * 40 + 8 * fq);
        const bf16x8 b0 = *(const LAS bf16x8*)(AT + fr * 40 + 8 * fq), b1 = *(const LAS bf16x8*)(AT + (16 + fr) * 40 + 8 * fq);
        const f32x4 zero = (f32x4){0.f, 0.f, 0.f, 0.f};
        const f32x4 o0 = MFMA16(a, b0, zero), o1 = MFMA16(a, b1, zero);
        oiv = (v4u){pk2(o0[0], o0[1]), pk2(o0[2], o0[3]), pk2(o1[0], o1[1]), pk2(o1[2], o1[3])}; }
    const v4u itl = *(const LAS v4u*)(IT + (tid >> 2) * 40 + (tid & 3) * 8), ktl = *(const LAS v4u*)(lds + HG_KT + ((tid >> 2) * 40 + (tid & 3) * 8) * 2);
    const v4u dll = *(const LAS v4u*)(lds + HG_DLS + (tid & 31) * 16);
    asm volatile("s_waitcnt vmcnt(0)" ::: "memory");
    __syncthreads();
    if (tid == 0 && prev >= 0) __hip_atomic_store(A.flags + (size_t)prev * 16, 1u, __ATOMIC_RELAXED, __HIP_MEMORY_SCOPE_AGENT);
    __builtin_amdgcn_raw_buffer_store_b128(itl, rIT, (unsigned)(it * 8192 + tid * 16), 0, 16);
    __builtin_amdgcn_raw_buffer_store_b128(ktl, rKE, (unsigned)(it * 8192 + tid * 16), 0, 16);
    if (tid < 32) __builtin_amdgcn_raw_buffer_store_b128(dll, HG_RSRC(A.DL, 2 << 20), (unsigned)(it * 1024 + tid * 16), 0, 16);
    __builtin_amdgcn_raw_buffer_store_b128(qfv, rQF, (unsigned)(((it * 8 + w) * 64 + lane) * 16), 0, 16);
    __builtin_amdgcn_raw_buffer_store_b128(oiv, rOI, (unsigned)(((it * 8 + w) * 64 + lane) * 16), 0, 16);
}
__device__ __forceinline__ void hgrn_pre_publish_last(const HgArgs& A, int last, int tid) {
    asm volatile("s_waitcnt vmcnt(0)" ::: "memory"); __syncthreads();
    if (tid == 0 && last >= 0) __hip_atomic_store(A.flags + (size_t)last * 16, 1u, __ATOMIC_RELAXED, __HIP_MEMORY_SCOPE_AGENT);
}
constexpr int SH_QF = 0, SH_KET = 8192, SH_DL = 16384, SH_BUF = 16896, SH_SS = 2 * SH_BUF;
struct ScanRegs { v4u qf, ke, it, oi, dl; v2u g0, g1; };
template <bool DRY> __device__ __forceinline__ void hgrn_scan_item(const HgArgs& A, int bh, LAS unsigned char* lds, int tid) {
    const int b = bh >> 3, h = bh & 7, lane = tid & 63, w = __builtin_amdgcn_readfirstlane(tid >> 6), fr = lane & 15, fq = lane >> 4;
    LAS float* SS = (LAS float*)(lds + SH_SS);
    f32x4 S[8];
#pragma unroll
    for (int kt = 0; kt < 8; ++kt) S[kt] = (f32x4){0.f, 0.f, 0.f, 0.f};
    const f32x4 go = *(const f32x4*)(A.gout + h * 128 + 16 * w + 4 * fq);
    const size_t it0 = (size_t)bh * 64;
    const __amdgpu_buffer_rsrc_t rQF = HG_RSRC(A.QF, 16 << 20), rKE = HG_RSRC(A.KET, 16 << 20), rIT = HG_RSRC(A.ITG, 16 << 20), rOI = HG_RSRC(A.OI, 16 << 20), rDL = HG_RSRC(A.DL, 2 << 20);
    const unsigned oQF = (unsigned)(((it0 * 8 + w) * 64 + lane) * 16), oKE = (unsigned)(((it0 * 128 + 16 * w + fr) * 32 + 8 * fq) * 2), oDL = (unsigned)((it0 * 256 + 4 * (lane & 31)) * 4);
    const v2u* pG = (const v2u*)(A.PROJ + (size_t)(b * SEQ + fr) * INW + 5120 + h * 128 + 16 * w + 4 * fq);
    unsigned* fl = A.flags + it0 * 16;
#define SC_LOAD(R, cc) do { const unsigned _c = (unsigned)(cc); wait_flag(fl + _c * 16); \
        R.qf = __builtin_amdgcn_raw_buffer_load_b128(rQF, oQF + _c * 8192u, 0, 16); R.ke = __builtin_amdgcn_raw_buffer_load_b128(rKE, oKE + _c * 8192u, 0, 16); \
        R.it = __builtin_amdgcn_raw_buffer_load_b128(rIT, oKE + _c * 8192u, 0, 16); R.oi = __builtin_amdgcn_raw_buffer_load_b128(rOI, oQF + _c * 8192u, 0, 16); \
        R.g0 = pG[(size_t)_c * 49152]; R.g1 = pG[(size_t)_c * 49152 + 24576]; if (w == 0) R.dl = __builtin_amdgcn_raw_buffer_load_b128(rDL, oDL + _c * 1024u, 0, 16); } while (0)
    ScanRegs A0, A1, B0, B1;
#define SC_DRAIN(R) asm volatile("" : "+v"(R.qf), "+v"(R.ke), "+v"(R.it), "+v"(R.oi), "+v"(R.dl), "+v"(R.g0), "+v"(R.g1))
    A0.dl = (v4u){0u, 0u, 0u, 0u}; A1.dl = A0.dl; B0.dl = A0.dl; B1.dl = A0.dl;
    SC_LOAD(A0, 0); SC_LOAD(A1, 1); SC_LOAD(B0, 2); SC_LOAD(B1, 3);
    SC_DRAIN(A0); SC_DRAIN(A1); SC_DRAIN(B0); SC_DRAIN(B1);
    f32x4 og0 = (f32x4){0.f, 0.f, 0.f, 0.f}, og1 = (f32x4){0.f, 0.f, 0.f, 0.f};
#define SC_STEP(R, cc) do { const int c = (cc); \
        LAS unsigned char* shb = lds + (c & 1) * SH_BUF; \
        *(LAS v4u*)(shb + SH_QF + w * 1024 + lane * 16) = R.qf; *(LAS v4u*)(shb + SH_KET + w * 1024 + lane * 16) = R.ke; \
        if (w == 0 && lane < 32) *(LAS v4u*)(shb + SH_DL + lane * 16) = R.dl; \
        const v4u itv = R.it, oi = R.oi; const v2u g0 = R.g0, g1 = R.g1; \
        __syncthreads(); \
        if (c > 0) { const LAS float* ss = SS + ((c - 1) & 1) * 256; float s0 = 0.f, s1 = 0.f; \
            _Pragma("unroll") for (int g = 0; g < 8; ++g) { s0 += ss[g * 32 + fr]; s1 += ss[g * 32 + 16 + fr]; } \
            const float r0 = __builtin_amdgcn_rsqf(s0 * (1.0f / 128.0f) + EPS), r1 = __builtin_amdgcn_rsqf(s1 * (1.0f / 128.0f) + EPS); \
            const size_t row = (size_t)(b * SEQ + 32 * (c - 1) + fr); \
            *(v2u*)(A.MIXIN + row * DM + 1024 + h * 128 + 16 * w + 4 * fq) = (v2u){pk2(og0[0] * r0, og0[1] * r0), pk2(og0[2] * r0, og0[3] * r0)}; \
            *(v2u*)(A.MIXIN + (row + 16) * DM + 1024 + h * 128 + 16 * w + 4 * fq) = (v2u){pk2(og1[0] * r1, og1[1] * r1), pk2(og1[2] * r1, og1[3] * r1)}; } \
        bf16x8 qf[8]; \
        _Pragma("unroll") for (int i = 0; i < 8; ++i) qf[i] = *(const LAS bf16x8*)(shb + SH_QF + i * 1024 + lane * 16); \
        if (!DRY) asm volatile("" ::: "memory"); \
        f32x4 o0 = (f32x4){bflo(oi.x), bfhi(oi.x), bflo(oi.y), bfhi(oi.y)}, o1 = (f32x4){bflo(oi.z), bfhi(oi.z), bflo(oi.w), bfhi(oi.w)}; \
        _Pragma("unroll") for (int kb = 0; kb < 4; ++kb) { \
            const v4u sp = (v4u){pk2(S[2 * kb][0], S[2 * kb][1]), pk2(S[2 * kb][2], S[2 * kb][3]), pk2(S[2 * kb + 1][0], S[2 * kb + 1][1]), pk2(S[2 * kb + 1][2], S[2 * kb + 1][3])}; \
            const bf16x8 sa = __builtin_bit_cast(bf16x8, sp); \
            o0 = MFMA16(sa, qf[kb], o0); o1 = MFMA16(sa, qf[4 + kb], o1); } \
        { float p0 = (o0[0] * o0[0] + o0[1] * o0[1]) + (o0[2] * o0[2] + o0[3] * o0[3]), p1 = (o1[0] * o1[0] + o1[1] * o1[1]) + (o1[2] * o1[2] + o1[3] * o1[3]); \
            p0 += __shfl_xor(p0, 16); p0 += __shfl_xor(p0, 32); p1 += __shfl_xor(p1, 16); p1 += __shfl_xor(p1, 32); \
            LAS float* ssw = SS + (c & 1) * 256 + w * 32; if (fq == 0) { ssw[fr] = p0; ssw[16 + fr] = p1; } \
            og0 = (f32x4){o0[0] * go[0] * bflo(g0.x), o0[1] * go[1] * bfhi(g0.x), o0[2] * go[2] * bflo(g0.y), o0[3] * go[3] * bfhi(g0.y)}; \
            og1 = (f32x4){o1[0] * go[0] * bflo(g1.x), o1[1] * go[1] * bfhi(g1.x), o1[2] * go[2] * bflo(g1.y), o1[3] * go[3] * bfhi(g1.y)}; } \
        const bf16x8 ib = __builtin_bit_cast(bf16x8, itv); \
        _Pragma("unroll") for (int kt = 0; kt < 8; ++kt) { \
            const f32x4 d4 = *(const LAS f32x4*)(shb + SH_DL + (16 * kt + 4 * fq) * 4); \
            const bf16x8 ka = *(const LAS bf16x8*)(shb + SH_KET + kt * 1024 + lane * 16); \
            S[kt] = MFMA16(ka, ib, S[kt] * d4); } \
    } while (0)
    for (int c0 = 0; c0 < 64; c0 += 8) {
        SC_STEP(A0, c0); SC_STEP(A1, c0 + 1);
        SC_LOAD(A0, c0 + 4); SC_LOAD(A1, c0 + 5);
        SC_STEP(B0, c0 + 2); SC_STEP(B1, c0 + 3);
        SC_LOAD(B0, c0 + 6); SC_LOAD(B1, c0 + 7);
        SC_STEP(A0, c0 + 4); SC_STEP(A1, c0 + 5);
        if (c0 + 8 < 64) { SC_LOAD(A0, c0 + 8); SC_LOAD(A1, c0 + 9); }
        SC_STEP(B0, c0 + 6); SC_STEP(B1, c0 + 7);
        if (c0 + 8 < 64) { SC_LOAD(B0, c0 + 10); SC_LOAD(B1, c0 + 11); }
        SC_DRAIN(A0); SC_DRAIN(A1); SC_DRAIN(B0); SC_DRAIN(B1);
    }
    __syncthreads();
    {   const LAS float* ss = SS + (63 & 1) * 256;
        float s0 = 0.f, s1 = 0.f;
#pragma unroll
        for (int g = 0; g < 8; ++g) { s0 += ss[g * 32 + fr]; s1 += ss[g * 32 + 16 + fr]; }
        const float r0 = __builtin_amdgcn_rsqf(s0 * (1.0f / 128.0f) + EPS), r1 = __builtin_amdgcn_rsqf(s1 * (1.0f / 128.0f) + EPS);
        const size_t row = (size_t)(b * SEQ + 32 * 63 + fr);
        *(v2u*)(A.MIXIN + row * DM + 1024 + h * 128 + 16 * w + 4 * fq) = (v2u){pk2(og0[0] * r0, og0[1] * r0), pk2(og0[2] * r0, og0[3] * r0)};
        *(v2u*)(A.MIXIN + (row + 16) * DM + 1024 + h * 128 + 16 * w + 4 * fq) = (v2u){pk2(og1[0] * r1, og1[1] * r1), pk2(og1[2] * r1, og1[3] * r1)}; }
    float* sp = A.out + OUT_SP + ((size_t)((A.l * NB + b) * 8 + h) * 128) * 128;
#pragma unroll
    for (int kt = 0; kt < 8; ++kt)
#pragma unroll
        for (int r = 0; r < 4; ++r) sp[(size_t)(16 * kt + 4 * fq + r) * 128 + 16 * w + fr] = S[kt][r];
    __syncthreads();
#undef SC_LOAD
#undef SC_STEP
}
constexpr int S2_QF = 0, S2_KET = 8192, S2_DL = 16384, S2_BUF = 16896, S2_SF = 2 * S2_BUF, S2_SS = S2_SF + 2 * 32768;
struct ScanRegs2 { v4u qf, ke, a0, a1, dl; v2u g00, g01, g10, g11; };
__device__ __forceinline__ void hgrn_scan_item2(const HgArgs& A, int bh, LAS unsigned char* lds, int tid) {
    const int b = bh >> 3, h = bh & 7, lane = tid & 63, w = __builtin_amdgcn_readfirstlane(tid >> 6), fr = lane & 15, fq = lane >> 4;
    const bool srole = w < 4; const int k2 = w & 3, vt0 = 2 * k2, vt1 = 2 * k2 + 1;
    LAS float* SS = (LAS float*)(lds + S2_SS);
    f32x4 X[16];
#pragma unroll
    for (int kt = 0; kt < 16; ++kt) X[kt] = (f32x4){0.f, 0.f, 0.f, 0.f};
    const f32x4 go0 = *(const f32x4*)(A.gout + h * 128 + 16 * vt0 + 4 * fq), go1 = *(const f32x4*)(A.gout + h * 128 + 16 * vt1 + 4 * fq);
    const size_t it0 = (size_t)bh * 64;
    const __amdgpu_buffer_rsrc_t rQF = HG_RSRC(A.QF, 16 << 20), rKE = HG_RSRC(A.KET, 16 << 20), rIT = HG_RSRC(A.ITG, 16 << 20), rOI = HG_RSRC(A.OI, 16 << 20), rDL = HG_RSRC(A.DL, 2 << 20);
    const unsigned oQF = (unsigned)(((it0 * 8 + w) * 64 + lane) * 16), oKE = (unsigned)(((it0 * 128 + 16 * w + fr) * 32 + 8 * fq) * 2), oDL = (unsigned)((it0 * 256 + 4 * (lane & 31)) * 4);
    const unsigned oIT0 = (unsigned)(((it0 * 128 + 16 * vt0 + fr) * 32 + 8 * fq) * 2), oOI0 = (unsigned)(((it0 * 8 + vt0) * 64 + lane) * 16);
    const v2u* pG = (const v2u*)(A.PROJ + (size_t)(b * SEQ + fr) * INW + 5120 + h * 128 + 16 * vt0 + 4 * fq);
    unsigned* fl = A.flags + it0 * 16;
#define S2_LOAD(R, cc) do { const unsigned _c = (unsigned)(cc); \
        R.qf = __builtin_amdgcn_raw_buffer_load_b128(rQF, oQF + _c * 8192u, 0, 16); R.ke = __builtin_amdgcn_raw_buffer_load_b128(rKE, oKE + _c * 8192u, 0, 16); \
        if (w == 0) R.dl = __builtin_amdgcn_raw_buffer_load_b128(rDL, oDL + _c * 1024u, 0, 16); \
        if (srole) { R.a0 = __builtin_amdgcn_raw_buffer_load_b128(rIT, oIT0 + _c * 8192u, 0, 16); R.a1 = __builtin_amdgcn_raw_buffer_load_b128(rIT, oIT0 + 1024u + _c * 8192u, 0, 16); } \
        else { R.a0 = __builtin_amdgcn_raw_buffer_load_b128(rOI, oOI0 + _c * 8192u, 0, 16); R.a1 = __builtin_amdgcn_raw_buffer_load_b128(rOI, oOI0 + 1024u + _c * 8192u, 0, 16); \
               const v2u* _g = pG + (size_t)_c * 49152; R.g00 = _g[0]; R.g01 = _g[24576]; R.g10 = _g[4]; R.g11 = _g[24580]; } } while (0)
#define S2_DRAIN(R) asm volatile("" : "+v"(R.qf), "+v"(R.ke), "+v"(R.a0), "+v"(R.a1), "+v"(R.dl), "+v"(R.g00), "+v"(R.g01), "+v"(R.g10), "+v"(R.g11))
    ScanRegs2 RA, RB, RC;
    { const v4u z4 = (v4u){0u, 0u, 0u, 0u}; const v2u z2 = (v2u){0u, 0u};
      RA.dl = z4; RB.dl = z4; RC.dl = z4; RA.g00 = z2; RA.g01 = z2; RA.g10 = z2; RA.g11 = z2; RB.g00 = z2; RB.g01 = z2; RB.g10 = z2; RB.g11 = z2; RC.g00 = z2; RC.g01 = z2; RC.g10 = z2; RC.g11 = z2; }
    wait_flags<3>(fl);
    S2_LOAD(RA, 0); S2_LOAD(RB, 1); S2_LOAD(RC, 2);
    S2_DRAIN(RA); S2_DRAIN(RB); S2_DRAIN(RC);
#define S2_FINISH(cp) do { const LAS float* ss = SS + ((cp) & 1) * 128; float s0 = 0.f, s1 = 0.f; \
        _Pragma("unroll") for (int g = 0; g < 4; ++g) { s0 += ss[g * 32 + fr]; s1 += ss[g * 32 + 16 + fr]; } \
        const float r0 = __builtin_amdgcn_rsqf(s0 * (1.0f / 128.0f) + EPS), r1 = __builtin_amdgcn_rsqf(s1 * (1.0f / 128.0f) + EPS); \
        bf16* orow = A.MIXIN + (size_t)(b * SEQ + 32 * (cp) + fr) * DM + 1024 + h * 128 + 16 * vt0 + 4 * fq; \
        *(v2u*)(orow) = (v2u){pk2(X[0][0] * r0, X[0][1] * r0), pk2(X[0][2] * r0, X[0][3] * r0)}; *(v2u*)(orow + 16) = (v2u){pk2(X[2][0] * r0, X[2][1] * r0), pk2(X[2][2] * r0, X[2][3] * r0)}; \
        *(v2u*)(orow + (size_t)16 * DM) = (v2u){pk2(X[1][0] * r1, X[1][1] * r1), pk2(X[1][2] * r1, X[1][3] * r1)}; *(v2u*)(orow + (size_t)16 * DM + 16) = (v2u){pk2(X[3][0] * r1, X[3][1] * r1), pk2(X[3][2] * r1, X[3][3] * r1)}; } while (0)
#define S2_STEP(R, cc) do { const int c = (cc); \
        LAS unsigned char* shb = lds + (c & 1) * S2_BUF; \
        *(LAS v4u*)(shb + S2_QF + w * 1024 + lane * 16) = R.qf; *(LAS v4u*)(shb + S2_KET + w * 1024 + lane * 16) = R.ke; \
        if (w == 0 && lane < 32) *(LAS v4u*)(shb + S2_DL + lane * 16) = R.dl; \
        const v4u a0 = R.a0, a1 = R.a1; const v2u g00 = R.g00, g01 = R.g01, g10 = R.g10, g11 = R.g11; \
        __syncthreads(); \
        if (srole) { \
            const bf16x8 ib0 = __builtin_bit_cast(bf16x8, a0), ib1 = __builtin_bit_cast(bf16x8, a1); \
            _Pragma("unroll") for (int kt = 0; kt < 8; ++kt) { \
                const f32x4 d4 = *(const LAS f32x4*)(shb + S2_DL + (16 * kt + 4 * fq) * 4); \
                const bf16x8 ka = *(const LAS bf16x8*)(shb + S2_KET + kt * 1024 + lane * 16); \
                X[kt] = MFMA16(ka, ib0, X[kt] * d4); X[8 + kt] = MFMA16(ka, ib1, X[8 + kt] * d4); } \
            LAS unsigned char* sf = lds + S2_SF + ((c + 1) & 1) * 32768 + lane * 16; \
            _Pragma("unroll") for (int kb = 0; kb < 4; ++kb) { \
                *(LAS v4u*)(sf + (vt0 * 4 + kb) * 1024) = (v4u){pk2(X[2 * kb][0], X[2 * kb][1]), pk2(X[2 * kb][2], X[2 * kb][3]), pk2(X[2 * kb + 1][0], X[2 * kb + 1][1]), pk2(X[2 * kb + 1][2], X[2 * kb + 1][3])}; \
                *(LAS v4u*)(sf + (vt1 * 4 + kb) * 1024) = (v4u){pk2(X[8 + 2 * kb][0], X[8 + 2 * kb][1]), pk2(X[8 + 2 * kb][2], X[8 + 2 * kb][3]), pk2(X[8 + 2 * kb + 1][0], X[8 + 2 * kb + 1][1]), pk2(X[8 + 2 * kb + 1][2], X[8 + 2 * kb + 1][3])}; } \
        } else { \
            if (c > 0) S2_FINISH(c - 1); \
            f32x4 o00 = (f32x4){bflo(a0.x), bfhi(a0.x), bflo(a0.y), bfhi(a0.y)}, o01 = (f32x4){bflo(a0.z), bfhi(a0.z), bflo(a0.w), bfhi(a0.w)}; \
            f32x4 o10 = (f32x4){bflo(a1.x), bfhi(a1.x), bflo(a1.y), bfhi(a1.y)}, o11 = (f32x4){bflo(a1.z), bfhi(a1.z), bflo(a1.w), bfhi(a1.w)}; \
            if (c > 0) { const LAS unsigned char* sf = lds + S2_SF + (c & 1) * 32768 + lane * 16; \
                _Pragma("unroll") for (int kb = 0; kb < 4; ++kb) { \
                    const bf16x8 sa0 = *(const LAS bf16x8*)(sf + (vt0 * 4 + kb) * 1024), sa1 = *(const LAS bf16x8*)(sf + (vt1 * 4 + kb) * 1024); \
                    const bf16x8 q0 = *(const LAS bf16x8*)(shb + S2_QF + kb * 1024 + lane * 16), q1 = *(const LAS bf16x8*)(shb + S2_QF + (4 + kb) * 1024 + lane * 16); \
                    o00 = MFMA16(sa0, q0, o00); o01 = MFMA16(sa0, q1, o01); o10 = MFMA16(sa1, q0, o10); o11 = MFMA16(sa1, q1, o11); } } \
            float p0 = ((o00[0] * o00[0] + o00[1] * o00[1]) + (o00[2] * o00[2] + o00[3] * o00[3])) + ((o10[0] * o10[0] + o10[1] * o10[1]) + (o10[2] * o10[2] + o10[3] * o10[3])); \
            float p1 = ((o01[0] * o01[0] + o01[1] * o01[1]) + (o01[2] * o01[2] + o01[3] * o01[3])) + ((o11[0] * o11[0] + o11[1] * o11[1]) + (o11[2] * o11[2] + o11[3] * o11[3])); \
            p0 += __shfl_xor(p0, 16); p0 += __shfl_xor(p0, 32); p1 += __shfl_xor(p1, 16); p1 += __shfl_xor(p1, 32); \
            LAS float* ssw = SS + (c & 1) * 128 + k2 * 32; if (fq == 0) { ssw[fr] = p0; ssw[16 + fr] = p1; } \
            X[0] = (f32x4){o00[0] * go0[0] * bflo(g00.x), o00[1] * go0[1] * bfhi(g00.x), o00[2] * go0[2] * bflo(g00.y), o00[3] * go0[3] * bfhi(g00.y)}; \
            X[1] = (f32x4){o01[0] * go0[0] * bflo(g01.x), o01[1] * go0[1] * bfhi(g01.x), o01[2] * go0[2] * bflo(g01.y), o01[3] * go0[3] * bfhi(g01.y)}; \
            X[2] = (f32x4){o10[0] * go1[0] * bflo(g10.x), o10[1] * go1[1] * bfhi(g10.x), o10[2] * go1[2] * bflo(g10.y), o10[3] * go1[3] * bfhi(g10.y)}; \
            X[3] = (f32x4){o11[0] * go1[0] * bflo(g11.x), o11[1] * go1[1] * bfhi(g11.x), o11[2] * go1[2] * bflo(g11.y), o11[3] * go1[3] * bfhi(g11.y)}; \
        } \
    } while (0)
    for (int c0 = 0; c0 < 60; c0 += 6) {
        wait_flags<6>(fl + (c0 + 3) * 16);
        S2_STEP(RA, c0); S2_LOAD(RA, c0 + 3);
        S2_STEP(RB, c0 + 1); S2_LOAD(RB, c0 + 4);
        S2_STEP(RC, c0 + 2); S2_LOAD(RC, c0 + 5);
        S2_STEP(RA, c0 + 3); S2_LOAD(RA, c0 + 6);
        S2_STEP(RB, c0 + 4); S2_LOAD(RB, c0 + 7);
        S2_STEP(RC, c0 + 5); S2_LOAD(RC, c0 + 8);
        S2_DRAIN(RA); S2_DRAIN(RB); S2_DRAIN(RC);
    }
    wait_flags<1>(fl + 63 * 16);
    S2_STEP(RA, 60); S2_LOAD(RA, 63); S2_STEP(RB, 61); S2_STEP(RC, 62); S2_DRAIN(RA); S2_STEP(RA, 63);
    __syncthreads();
    if (!srole) S2_FINISH(63);
    else { float* sp = A.out + OUT_SP + ((size_t)((A.l * NB + b) * 8 + h) * 128) * 128;
#pragma unroll
        for (int kt = 0; kt < 8; ++kt)
#pragma unroll
            for (int r = 0; r < 4; ++r) { sp[(size_t)(16 * kt + 4 * fq + r) * 128 + 16 * vt0 + fr] = X[kt][r]; sp[(size_t)(16 * kt + 4 * fq + r) * 128 + 16 * vt1 + fr] = X[8 + kt][r]; } }
    __syncthreads();
#undef S2_LOAD
#undef S2_DRAIN
#undef S2_FINISH
#undef S2_STEP
}
template <int N> __device__ __forceinline__ void wait_flags_clamped(unsigned* fl, int first) {
    for (unsigned sp = 0u;; ) { unsigned ok = 1u;
#pragma unroll
        for (int i = 0; i < N; ++i) { const int c = (first + i < 63) ? first + i : 63; ok &= (__hip_atomic_load(fl + c * 16, __ATOMIC_RELAXED, __HIP_MEMORY_SCOPE_AGENT) != 0u) ? 1u : 0u; }
        if (ok) break; __builtin_amdgcn_s_sleep(4); if (++sp > (1u << 17)) break; }
    asm volatile("" ::: "memory");
}
struct S3RegS { v4u f0, f1, a0, a1, dl; };
struct S3RegO { v4u f0, f1, a0, a1, gA, gB; };
constexpr int S3_G = S2_SS + 1024, S3_GROW = 272;
template <bool POLL> __device__ __forceinline__ void hgrn_scan_item3(const HgArgs& A, int bh, LAS unsigned char* lds, int tid) {
    const int b = bh >> 3, h = bh & 7, lane = tid & 63, w = __builtin_amdgcn_readfirstlane(tid >> 6), fr = lane & 15, fq = lane >> 4;
    const int k2 = w & 3, vt0 = 2 * k2, vt1 = 2 * k2 + 1;
    LAS float* SS = (LAS float*)(lds + S2_SS);
    const size_t it0 = (size_t)bh * 64;
    unsigned* fl = A.flags + it0 * 16;
#define S3_CL(cc) ((unsigned)(((cc) < 63) ? (cc) : 63))
#define S3_FLD(cc) __hip_atomic_load(fl + S3_CL(cc) * 16, __ATOMIC_RELAXED, __HIP_MEMORY_SCOPE_AGENT)
#define S3_FCHK(F, cc) do { if (__builtin_amdgcn_readfirstlane(F) == 0u) { unsigned _sp = 0u; while (S3_FLD(cc) == 0u) { __builtin_amdgcn_s_sleep(2); if (++_sp > (1u << 17)) break; } } asm volatile("" ::: "memory"); } while (0)
    if (w < 4) {
        const __amdgpu_buffer_rsrc_t rKE = HG_RSRC(A.KET, 16 << 20), rIT = HG_RSRC(A.ITG, 16 << 20), rDL = HG_RSRC(A.DL, 2 << 20);
        const unsigned oK = (unsigned)(((it0 * 128 + 16 * vt0 + fr) * 32 + 8 * fq) * 2), oDL = (unsigned)((it0 * 256 + 4 * (lane & 31)) * 4);
        f32x4 X[16];
#pragma unroll
        for (int kt = 0; kt < 16; ++kt) X[kt] = (f32x4){0.f, 0.f, 0.f, 0.f};
        S3RegS R[6];
#define S3S_LOAD(i, cc) do { const unsigned _o = S3_CL(cc) * 8192u; \
            R[i].f0 = __builtin_amdgcn_raw_buffer_load_b128(rKE, oK + _o, 0, 16); R[i].f1 = __builtin_amdgcn_raw_buffer_load_b128(rKE, oK + 1024u + _o, 0, 16); \
            R[i].a0 = __builtin_amdgcn_raw_buffer_load_b128(rIT, oK + _o, 0, 16); R[i].a1 = __builtin_amdgcn_raw_buffer_load_b128(rIT, oK + 1024u + _o, 0, 16); \
            R[i].dl = __builtin_amdgcn_raw_buffer_load_b128(rDL, oDL + S3_CL(cc) * 1024u, 0, 16); } while (0)
#define S3S_STEP(i, cc) do { const int c = (cc); \
            LAS unsigned char* shb = lds + (c & 1) * S2_BUF; \
            *(LAS v4u*)(shb + S2_KET + vt0 * 1024 + lane * 16) = R[i].f0; *(LAS v4u*)(shb + S2_KET + vt1 * 1024 + lane * 16) = R[i].f1; \
            if (w == 0 && lane < 32) *(LAS v4u*)(shb + S2_DL + lane * 16) = R[i].dl; \
            const bf16x8 ib0 = __builtin_bit_cast(bf16x8, R[i].a0), ib1 = __builtin_bit_cast(bf16x8, R[i].a1); \
            __syncthreads(); \
            _Pragma("unroll") for (int kt = 0; kt < 8; ++kt) { \
                const f32x4 d4 = *(const LAS f32x4*)(shb + S2_DL + (16 * kt + 4 * fq) * 4); \
                const bf16x8 ka = *(const LAS bf16x8*)(shb + S2_KET + kt * 1024 + lane * 16); \
                X[kt] = MFMA16(ka, ib0, X[kt] * d4); X[8 + kt] = MFMA16(ka, ib1, X[8 + kt] * d4); } \
            LAS unsigned char* sf = lds + S2_SF + ((c + 1) & 1) * 32768 + lane * 16; \
            _Pragma("unroll") for (int kb = 0; kb < 4; ++kb) { \
                *(LAS v4u*)(sf + (vt0 * 4 + kb) * 1024) = (v4u){pk2(X[2 * kb][0], X[2 * kb][1]), pk2(X[2 * kb][2], X[2 * kb][3]), pk2(X[2 * kb + 1][0], X[2 * kb + 1][1]), pk2(X[2 * kb + 1][2], X[2 * kb + 1][3])}; \
                *(LAS v4u*)(sf + (vt1 * 4 + kb) * 1024) = (v4u){pk2(X[8 + 2 * kb][0], X[8 + 2 * kb][1]), pk2(X[8 + 2 * kb][2], X[8 + 2 * kb][3]), pk2(X[8 + 2 * kb + 1][0], X[8 + 2 * kb + 1][1]), pk2(X[8 + 2 * kb + 1][2], X[8 + 2 * kb + 1][3])}; } \
        } while (0)
#define S3S_SL(s) do { S3S_STEP((s) % 6, c0 + (s)); if (POLL) S3_FCHK(F[(s) % 3], c0 + (s) + 6); S3S_LOAD((s) % 6, c0 + (s) + 6); if (POLL) F[(s) % 3] = S3_FLD(c0 + (s) + 9); } while (0)
#define S3S_TRIP(cb) do { const int c0 = (cb); S3S_SL(0); S3S_SL(1); S3S_SL(2); S3S_SL(3); S3S_SL(4); S3S_SL(5); S3S_SL(6); S3S_SL(7); S3S_SL(8); S3S_SL(9); S3S_SL(10); S3S_SL(11); } while (0)
        unsigned F[3] = {1u, 1u, 1u};
        if (POLL) { wait_flags_clamped<6>(fl, 0); F[0] = S3_FLD(6); F[1] = S3_FLD(7); F[2] = S3_FLD(8); }
        S3S_LOAD(0, 0); S3S_LOAD(1, 1); S3S_LOAD(2, 2); S3S_LOAD(3, 3); S3S_LOAD(4, 4); S3S_LOAD(5, 5);
        S3S_TRIP(0); S3S_TRIP(12); S3S_TRIP(24); S3S_TRIP(36); S3S_TRIP(48);
        S3S_STEP(0, 60); S3S_STEP(1, 61); S3S_STEP(2, 62); S3S_STEP(3, 63);
        __syncthreads();
        float* sp = A.out + OUT_SP + ((size_t)((A.l * NB + b) * 8 + h) * 128) * 128;
#pragma unroll
        for (int kt = 0; kt < 8; ++kt)
#pragma unroll
            for (int r = 0; r < 4; ++r) { sp[(size_t)(16 * kt + 4 * fq + r) * 128 + 16 * vt0 + fr] = X[kt][r]; sp[(size_t)(16 * kt + 4 * fq + r) * 128 + 16 * vt1 + fr] = X[8 + kt][r]; }
        __syncthreads();
#undef S3S_LOAD
#undef S3S_STEP
#undef S3S_SL
#undef S3S_TRIP
    } else {
        const __amdgpu_buffer_rsrc_t rQF = HG_RSRC(A.QF, 16 << 20), rOI = HG_RSRC(A.OI, 16 << 20);
        const unsigned oQ = (unsigned)(((it0 * 8 + vt0) * 64 + lane) * 16);
        const char* pG = (const char*)(A.PROJ + (size_t)(b * SEQ + 8 * k2 + (lane >> 4)) * INW + 5120 + h * 128) + (lane & 15) * 16;
        const f32x4 go0 = *(const f32x4*)(A.gout + h * 128 + 16 * vt0 + 4 * fq), go1 = *(const f32x4*)(A.gout + h * 128 + 16 * vt1 + 4 * fq);
        f32x4 og00 = (f32x4){0.f, 0.f, 0.f, 0.f}, og01 = og00, og10 = og00, og11 = og00;
        S3RegO R[6];
#define S3O_LOAD(i, cc) do { const unsigned _o = S3_CL(cc) * 8192u; const char* _g = pG + (size_t)S3_CL(cc) * (32 * INW * 2); \
            R[i].f0 = __builtin_amdgcn_raw_buffer_load_b128(rQF, oQ + _o, 0, 16); R[i].f1 = __builtin_amdgcn_raw_buffer_load_b128(rQF, oQ + 1024u + _o, 0, 16); \
            R[i].a0 = __builtin_amdgcn_raw_buffer_load_b128(rOI, oQ + _o, 0, 16); R[i].a1 = __builtin_amdgcn_raw_buffer_load_b128(rOI, oQ + 1024u + _o, 0, 16); \
            R[i].gA = *(const v4u*)_g; R[i].gB = *(const v4u*)(_g + 4 * INW * 2); } while (0)
#define S3O_FINISH(cp) do { const LAS float* ss = SS + ((cp) & 1) * 128; float s0 = 0.f, s1 = 0.f; \
            _Pragma("unroll") for (int g = 0; g < 4; ++g) { s0 += ss[g * 32 + fr]; s1 += ss[g * 32 + 16 + fr]; } \
            const float r0 = __builtin_amdgcn_rsqf(s0 * (1.0f / 128.0f) + EPS), r1 = __builtin_amdgcn_rsqf(s1 * (1.0f / 128.0f) + EPS); \
            bf16* orow = A.MIXIN + (size_t)(b * SEQ + 32 * (cp) + fr) * DM + 1024 + h * 128 + 16 * vt0 + 4 * fq; \
            *(v2u*)(orow) = (v2u){pk2(og00[0] * r0, og00[1] * r0), pk2(og00[2] * r0, og00[3] * r0)}; *(v2u*)(orow + 16) = (v2u){pk2(og10[0] * r0, og10[1] * r0), pk2(og10[2] * r0, og10[3] * r0)}; \
            *(v2u*)(orow + (size_t)16 * DM) = (v2u){pk2(og01[0] * r1, og01[1] * r1), pk2(og01[2] * r1, og01[3] * r1)}; *(v2u*)(orow + (size_t)16 * DM + 16) = (v2u){pk2(og11[0] * r1, og11[1] * r1), pk2(og11[2] * r1, og11[3] * r1)}; } while (0)
#define S3O_STEP(i, cc) do { const int c = (cc); \
            LAS unsigned char* shb = lds + (c & 1) * S2_BUF; \
            *(LAS v4u*)(shb + S2_QF + vt0 * 1024 + lane * 16) = R[i].f0; *(LAS v4u*)(shb + S2_QF + vt1 * 1024 + lane * 16) = R[i].f1; \
            { LAS unsigned char* gw = lds + S3_G + (c & 1) * (32 * S3_GROW) + (8 * k2 + (lane >> 4)) * S3_GROW + (lane & 15) * 16; *(LAS v4u*)gw = R[i].gA; *(LAS v4u*)(gw + 4 * S3_GROW) = R[i].gB; } \
            const v4u a0 = R[i].a0, a1 = R[i].a1; \
            __syncthreads(); \
            const LAS unsigned char* gr = lds + S3_G + (c & 1) * (32 * S3_GROW) + fr * S3_GROW + (16 * vt0 + 4 * fq) * 2; \
            const v2u g00 = *(const LAS v2u*)gr, g01 = *(const LAS v2u*)(gr + 16 * S3_GROW), g10 = *(const LAS v2u*)(gr + 32), g11 = *(const LAS v2u*)(gr + 16 * S3_GROW + 32); \
            if (c > 0) S3O_FINISH(c - 1); \
            f32x4 o00 = (f32x4){bflo(a0.x), bfhi(a0.x), bflo(a0.y), bfhi(a0.y)}, o01 = (f32x4){bflo(a0.z), bfhi(a0.z), bflo(a0.w), bfhi(a0.w)}; \
            f32x4 o10 = (f32x4){bflo(a1.x), bfhi(a1.x), bflo(a1.y), bfhi(a1.y)}, o11 = (f32x4){bflo(a1.z), bfhi(a1.z), bflo(a1.w), bfhi(a1.w)}; \
            if (c > 0) { const LAS unsigned char* sf = lds + S2_SF + (c & 1) * 32768 + lane * 16; \
                _Pragma("unroll") for (int kb = 0; kb < 4; ++kb) { \
                    const bf16x8 sa0 = *(const LAS bf16x8*)(sf + (vt0 * 4 + kb) * 1024), sa1 = *(const LAS bf16x8*)(sf + (vt1 * 4 + kb) * 1024); \
                    const bf16x8 q0 = *(const LAS bf16x8*)(shb + S2_QF + kb * 1024 + lane * 16), q1 = *(const LAS bf16x8*)(shb + S2_QF + (4 + kb) * 1024 + lane * 16); \
                    o00 = MFMA16(sa0, q0, o00); o01 = MFMA16(sa0, q1, o01); o10 = MFMA16(sa1, q0, o10); o11 = MFMA16(sa1, q1, o11); } } \
            float p0 = ((o00[0] * o00[0] + o00[1] * o00[1]) + (o00[2] * o00[2] + o00[3] * o00[3])) + ((o10[0] * o10[0] + o10[1] * o10[1]) + (o10[2] * o10[2] + o10[3] * o10[3])); \
            float p1 = ((o01[0] * o01[0] + o01[1] * o01[1]) + (o01[2] * o01[2] + o01[3] * o01[3])) + ((o11[0] * o11[0] + o11[1] * o11[1]) + (o11[2] * o11[2] + o11[3] * o11[3])); \
            p0 += __shfl_xor(p0, 16); p0 += __shfl_xor(p0, 32); p1 += __shfl_xor(p1, 16); p1 += __shfl_xor(p1, 32); \
            LAS float* ssw = SS + (c & 1) * 128 + k2 * 32; if (fq == 0) { ssw[fr] = p0; ssw[16 + fr] = p1; } \
            og00 = (f32x4){o00[0] * go0[0] * bflo(g00.x), o00[1] * go0[1] * bfhi(g00.x), o00[2] * go0[2] * bflo(g00.y), o00[3] * go0[3] * bfhi(g00.y)}; \
            og01 = (f32x4){o01[0] * go0[0] * bflo(g01.x), o01[1] * go0[1] * bfhi(g01.x), o01[2] * go0[2] * bflo(g01.y), o01[3] * go0[3] * bfhi(g01.y)}; \
            og10 = (f32x4){o10[0] * go1[0] * bflo(g10.x), o10[1] * go1[1] * bfhi(g10.x), o10[2] * go1[2] * bflo(g10.y), o10[3] * go1[3] * bfhi(g10.y)}; \
            og11 = (f32x4){o11[0] * go1[0] * bflo(g11.x), o11[1] * go1[1] * bfhi(g11.x), o11[2] * go1[2] * bflo(g11.y), o11[3] * go1[3] * bfhi(g11.y)}; \
        } while (0)
#define S3O_SL(s) do { S3O_STEP((s) % 6, c0 + (s)); if (POLL) S3_FCHK(F[(s) % 3], c0 + (s) + 6); S3O_LOAD((s) % 6, c0 + (s) + 6); if (POLL) F[(s) % 3] = S3_FLD(c0 + (s) + 9); } while (0)
#define S3O_TRIP(cb) do { const int c0 = (cb); S3O_SL(0); S3O_SL(1); S3O_SL(2); S3O_SL(3); S3O_SL(4); S3O_SL(5); S3O_SL(6); S3O_SL(7); S3O_SL(8); S3O_SL(9); S3O_SL(10); S3O_SL(11); } while (0)
        unsigned F[3] = {1u, 1u, 1u};
        if (POLL) { wait_flags_clamped<6>(fl, 0); F[0] = S3_FLD(6); F[1] = S3_FLD(7); F[2] = S3_FLD(8); }
        S3O_LOAD(0, 0); S3O_LOAD(1, 1); S3O_LOAD(2, 2); S3O_LOAD(3, 3); S3O_LOAD(4, 4); S3O_LOAD(5, 5);
        S3O_TRIP(0); S3O_TRIP(12); S3O_TRIP(24); S3O_TRIP(36); S3O_TRIP(48);
        S3O_STEP(0, 60); S3O_STEP(1, 61); S3O_STEP(2, 62); S3O_STEP(3, 63);
        __syncthreads();
        S3O_FINISH(63);
        __syncthreads();
#undef S3O_LOAD
#undef S3O_FINISH
#undef S3O_STEP
#undef S3O_SL
#undef S3O_TRIP
    }
#undef S3_CL
#undef S3_FLD
#undef S3_FCHK
}
__device__ __forceinline__ int mix_next_item(int j, int ob, int nb, int ng) {
    if (ng == 0) return j + nb;
    const int split = 8 * nb;
    if (j < split) { const int jn = j + nb; return (jn < split) ? jn : ((ob >= ng) ? split + (ob - ng) : 1 << 20); }
    return j + (nb - ng);
}
constexpr int GM_VT = 0, GM_WL = 34816, GM_MU = 69632;
__device__ __forceinline__ void gmlp2_item(const MixArgs& A, int b, int n, int h0, int h1, LAS unsigned char* lds, int tid) {
    LAS bf16* VT = (LAS bf16*)(lds + GM_VT); LAS bf16* WL = (LAS bf16*)(lds + GM_WL); LAS float* MU = (LAS float*)(lds + GM_MU); LAS float* RS = MU + 128;
    const int lane = tid & 63, w = tid >> 6, fr = lane & 15, fq = lane >> 4;
    const int m0_ = b * SEQ + 128 * n;
    { const int m0 = m0_;
#pragma unroll 4
    for (int r = 0; r < 16; ++r) { const size_t row = (size_t)(m0 + 16 * w + r);
        const v4u a = *(const v4u*)(A.PROJ + row * INW + 1024 + 8 * lane), c = *(const v4u*)(A.PROJ + row * INW + 1024 + 512 + 8 * lane);
        float x[16] = {bflo(a.x), bfhi(a.x), bflo(a.y), bfhi(a.y), bflo(a.z), bfhi(a.z), bflo(a.w), bfhi(a.w), bflo(c.x), bfhi(c.x), bflo(c.y), bfhi(c.y), bflo(c.z), bfhi(c.z), bflo(c.w), bfhi(c.w)};
        float s = 0.f;
#pragma unroll
        for (int i = 0; i < 16; ++i) s += x[i];
        const float mu = wave_sum(s) * (1.0f / 1024.0f); float q = 0.f;
#pragma unroll
        for (int i = 0; i < 16; ++i) { const float d = x[i] - mu; q += d * d; }
        const float rs = 1.0f / sqrtf(wave_sum(q) * (1.0f / 1024.0f) + EPS);
        if (lane == 0) { MU[16 * w + r] = mu; RS[16 * w + r] = rs; } }
    }
    __syncthreads();
    for (int h = h0; h < h1; ++h) {
        int m0 = __builtin_amdgcn_readfirstlane(m0_); asm volatile("" : "+s"(m0));
        {
            const int s = tid >> 2, dq = tid & 3; const size_t row = (size_t)(m0 + s); const float mu = MU[s], rs = RS[s];
#pragma unroll
            for (int i = 0; i < 4; ++i) { const int d0 = 32 * dq + 8 * i;
                const v4u a = *(const v4u*)(A.PROJ + row * INW + 1024 + h * 128 + d0);
                const f32x4 g0 = *(const f32x4*)(A.ln_g + h * 128 + d0), g1 = *(const f32x4*)(A.ln_g + h * 128 + d0 + 4), b0 = *(const f32x4*)(A.ln_b + h * 128 + d0), b1 = *(const f32x4*)(A.ln_b + h * 128 + d0 + 4);
                float vn[8] = {(bflo(a.x) - mu) * rs * g0[0] + b0[0], (bfhi(a.x) - mu) * rs * g0[1] + b0[1], (bflo(a.y) - mu) * rs * g0[2] + b0[2], (bfhi(a.y) - mu) * rs * g0[3] + b0[3],
                               (bflo(a.z) - mu) * rs * g1[0] + b1[0], (bfhi(a.z) - mu) * rs * g1[1] + b1[1], (bflo(a.w) - mu) * rs * g1[2] + b1[2], (bfhi(a.w) - mu) * rs * g1[3] + b1[3]};
                if (n == 15) { float* vp = A.out + OUT_VP + ((size_t)((A.l * NB + b) * 128 + s)) * 1024 + h * 128 + d0;
                    *(f32x4*)vp = (f32x4){vn[0], vn[1], vn[2], vn[3]}; *(f32x4*)(vp + 4) = (f32x4){vn[4], vn[5], vn[6], vn[7]}; }
#pragma unroll
                for (int e = 0; e < 8; ++e) VT[(d0 + e) * 136 + s] = (bf16)(pk2(vn[e], 0.f) & 0xffffu); }
        }
        {
            const int t = tid >> 2, sq = tid & 3; const float* wr = A.sw + ((size_t)h * 128 + t) * 128 + 32 * sq;
#pragma unroll
            for (int i = 0; i < 4; ++i) { const int s0 = 32 * sq + 8 * i; const f32x4 x0 = *(const f32x4*)(wr + 8 * i), x1 = *(const f32x4*)(wr + 8 * i + 4);
                v4u o; o.x = pk2(s0 + 0 <= t ? x0[0] : 0.f, s0 + 1 <= t ? x0[1] : 0.f); o.y = pk2(s0 + 2 <= t ? x0[2] : 0.f, s0 + 3 <= t ? x0[3] : 0.f);
                o.z = pk2(s0 + 4 <= t ? x1[0] : 0.f, s0 + 5 <= t ? x1[1] : 0.f); o.w = pk2(s0 + 6 <= t ? x1[2] : 0.f, s0 + 7 <= t ? x1[3] : 0.f);
                *(LAS v4u*)(WL + t * 136 + s0) = o; }
        }
        __syncthreads();
        f32x4 acc[8];
#pragma unroll
        for (int dt = 0; dt < 8; ++dt) acc[dt] = (f32x4){0.f, 0.f, 0.f, 0.f};
        const int nkb = (16 * w + 15) / 32 + 1;
        for (int kb = 0; kb < nkb; ++kb) { const bf16x8 wb = *(const LAS bf16x8*)(WL + (16 * w + fr) * 136 + 32 * kb + 8 * fq);
#pragma unroll
            for (int dt = 0; dt < 8; ++dt) { const bf16x8 va = *(const LAS bf16x8*)(VT + (16 * dt + fr) * 136 + 32 * kb + 8 * fq); acc[dt] = MFMA16(va, wb, acc[dt]); } }
        {   const int t = 16 * w + fr; const size_t row = (size_t)(m0 + t); const float bt = A.sb[h * 128 + t];
#pragma unroll
            for (int dt = 0; dt < 8; ++dt) { const v2u uu = *(const v2u*)(A.PROJ + row * INW + h * 128 + 16 * dt + 4 * fq);
                *(v2u*)(A.MIXIN + row * DM + h * 128 + 16 * dt + 4 * fq) = (v2u){pk2(bflo(uu.x) * (acc[dt][0] + bt), bfhi(uu.x) * (acc[dt][1] + bt)), pk2(bflo(uu.y) * (acc[dt][2] + bt), bfhi(uu.y) * (acc[dt][3] + bt))}; }
        }
        __syncthreads();
    }
}
__device__ __forceinline__ void hgrn_sample_loop(const MixArgs& A, int j0, int jstride, int jend, LAS unsigned char* lds, int tid) {
    if (j0 >= jend) return;
    LAS float* FK = (LAS float*)lds;
    LAS float* OPART = FK + 384;
    const int lane = tid & 63, w = tid >> 6, vq = lane & 31, par = lane >> 5;
    f32x4 sv[8];
    { const float* s0 = A.state_in + ((size_t)j0 * 128) * 128;
#pragma unroll
      for (int it = 0; it < 8; ++it) sv[it] = __builtin_nontemporal_load((const f32x4*)(s0 + (size_t)(16 * w + 2 * it + par) * 128 + 4 * vq)); }
    for (int j = j0; j < jend; j += jstride) {
        const int b = j >> 3, h = j & 7; const size_t row = (size_t)(MP + b);
        if (tid < 128) { const int k = tid; const float z = A.ZF[row * 1024 + h * 128 + k]; const float lbv = A.LB[A.l * 1024 + h * 128 + k]; const float sg = sigmoid_f(z);
            FK[k] = lbv + (1.0f - lbv) * sg; FK[128 + k] = (1.0f - lbv) * (1.0f - sg); FK[256 + k] = bf2f(A.PROJ[row * INW + 2048 + h * 128 + k]); }
        const v2u ib = *(const v2u*)(A.PROJ + row * INW + 4096 + h * 128 + 4 * vq);
        const f32x4 i4 = (f32x4){bflo(ib.x), bfhi(ib.x), bflo(ib.y), bfhi(ib.y)};
        __syncthreads();
        f32x4 cur[8];
#pragma unroll
        for (int it = 0; it < 8; ++it) cur[it] = sv[it];
        if (j + jstride < jend) { const float* s0 = A.state_in + ((size_t)(j + jstride) * 128) * 128;
#pragma unroll
            for (int it = 0; it < 8; ++it) sv[it] = __builtin_nontemporal_load((const f32x4*)(s0 + (size_t)(16 * w + 2 * it + par) * 128 + 4 * vq)); }
        float* s1 = A.out + OUT_SS + ((size_t)(A.l * MS * 8 + j) * 128) * 128;
        f32x4 o = (f32x4){0.f, 0.f, 0.f, 0.f};
#pragma unroll
        for (int it = 0; it < 8; ++it) { const int k = 16 * w + 2 * it + par; const float f = FK[k], kk = FK[128 + k], q = FK[256 + k];
            f32x4 sn; sn.x = f * cur[it].x + kk * i4.x; sn.y = f * cur[it].y + kk * i4.y; sn.z = f * cur[it].z + kk * i4.z; sn.w = f * cur[it].w + kk * i4.w;
            __builtin_nontemporal_store(sn, (f32x4*)(s1 + (size_t)k * 128 + 4 * vq));
            o.x += sn.x * q; o.y += sn.y * q; o.z += sn.z * q; o.w += sn.w * q; }
        o.x += __shfl_xor(o.x, 32); o.y += __shfl_xor(o.y, 32); o.z += __shfl_xor(o.z, 32); o.w += __shfl_xor(o.w, 32);
        if (par == 0) *(LAS f32x4*)(OPART + w * 128 + 4 * vq) = o;
        __syncthreads();
        if (w == 0) {
            float o0 = 0.f, o1 = 0.f;
#pragma unroll
            for (int g = 0; g < 8; ++g) { o0 += OPART[g * 128 + 2 * lane]; o1 += OPART[g * 128 + 2 * lane + 1]; }
            const float rstd = __builtin_amdgcn_rsqf(wave_sum(o0 * o0 + o1 * o1) * (1.0f / 128.0f) + EPS);
            const unsigned sg = *(const unsigned*)(A.PROJ + row * INW + 5120 + h * 128 + 2 * lane);
            const float g0 = A.gout[h * 128 + 2 * lane], g1 = A.gout[h * 128 + 2 * lane + 1];
            *(unsigned*)(A.MIXIN + row * DM + 1024 + h * 128 + 2 * lane) = pk2(o0 * rstd * g0 * bflo(sg), o1 * rstd * g1 * bfhi(sg));
        }
    }
    __syncthreads();
}
#define LAYER_BODY(L_) do { const int l = (L_); \
        const int pb = 1 + 5 * l; \
        if (IN(pb + 0)) { \
            { pg8::Gemm g{H, Win_t + (size_t)l * INW * DM, MP, INW, DM}; pg8::StaticOrder S; S.init(MP, INW, G, bid); \
            pg8::EpiIn E{PROJ, ZF}; \
            pg8::gemm_phase<pg8::EpiIn, pg8::StaticOrder, true, true>(lds, g, S, E); \
            if (DUP_GEMM & 1) pg8::gemm_phase<pg8::EpiIn, pg8::StaticOrder, true, true>(lds, g, S, E); \
            for (int su = bid; su < INW / 64; su += G) { \
                pg8::SEpiIn SE{PROJ + (size_t)MP * INW, ZF + (size_t)MP * AW, 64 * su}; \
                pg8::gemm_small_unit(lds, H + (size_t)MP * DM, DM, Win_t + (size_t)l * INW * DM, DM, 0, DM / 64, pg8::BRowLin{64 * su}, SE); } } \
            if (bid >= INW / 64 && G == 256) {      \
                asm volatile("s_waitcnt vmcnt(0) lgkmcnt(0)" ::: "memory"); __syncthreads(); \
                convert_layer(WP, l, (bid - INW / 64) * NWAVES + wave, (G - INW / 64) * NWAVES, (LAS float*)(lds + wave * 16384), lane, 8); } \
        } \
        SEAM(pb + 0); \
        if (IN(pb + 1)) { \
            MixArgs A; A.l = l; A.PROJ = PROJ; A.ZF = ZF; A.MIXIN = MIXIN; A.LB = LB; A.ln_g = ln_v_gain + l * 1024; A.ln_b = ln_v_bias + l * 1024; \
            A.sw = spatial_w + (size_t)l * 8 * 128 * 128; A.sb = spatial_b + l * 8 * 128; A.gout = hgrn_out_gain + l * 1024; \
            A.state_in = state_hgrn + (size_t)l * MS * 8 * 128 * 128; A.out = args.out; \
            HgArgs HA; HA.l = l; HA.PROJ = PROJ; HA.ZF = ZF; HA.LB = LB; HA.QF = HQF; HA.KET = HKET; HA.ITG = HIT; HA.OI = HOI; HA.DL = HDL; HA.MIXIN = MIXIN; HA.gout = hgrn_out_gain + l * 1024; HA.out = args.out; \
            HA.flags = (unsigned*)(ctl + CW_FLAG0) + (size_t)l * 2048 * 16; \
            if (bid < 32 && G > 32) { hgrn_scan_item3<true>(HA, bid, lds, tid); if (DUP_MIX & 2) hgrn_scan_item3<true>(HA, bid, lds, tid); } \
            else { \
                const int ob = bid - 32, nb = G - 32, ng = (nb >= 224) ? 128 : 0; \
                { int prev = -1; PreRegs PR; if (ob < 2048) hgrn_pre_load(HA, (ob & 31) * 64 + (ob >> 5), PR, tid); \
                  for (int j = ob; j < 2048; ) { const int it = (j & 31) * 64 + (j >> 5), jn = mix_next_item(j, ob, nb, ng); hgrn_pre_item(HA, it, prev, jn < 2048 ? (jn & 31) * 64 + (jn >> 5) : -1, PR, lds, tid); prev = it; j = jn; }      \
                  hgrn_pre_publish_last(HA, prev, tid); } \
                if (ng) { \
                    if (ob < ng) { gmlp2_item(A, ob >> 5, (ob >> 1) & 15, 4 * (ob & 1), 4 * (ob & 1) + 4, lds, tid); } \
                    else { if (ob - ng < 16) gmlp_sample_row(A, 8 * (ob - ng) + wave, lane); hgrn_sample_loop(A, ob - ng, nb - ng, 1024, lds, tid); } \
                } else { \
                    for (int it = ob; it < 64; it += nb) gmlp2_item(A, it >> 4, it & 15, 0, 8, lds, tid); \
                    for (int it = ob; it < 16; it += nb) gmlp_sample_row(A, 8 * it + wave, lane); \
                    hgrn_sample_loop(A, ob, nb, 1024, lds, tid); \
                } \
                if (G == 256) { asm volatile("s_waitcnt vmcnt(0) lgkmcnt(0)" ::: "memory"); __syncthreads(); convert_layer(WP, l, ob * NWAVES + wave, nb * NWAVES, (LAS float*)(lds + wave * 16384), lane, 9); }      \
            } \
        } \
        SEAM(pb + 1); \
        if (IN(pb + 2)) { \
            { pg8::Gemm g{MIXIN, Wout_t + (size_t)l * DM * DM, MP, DM, DM}; pg8::StaticOrder S; S.init(MP, DM, G, bid); \
            pg8::EpiB16WT E{MIXB, DM}; \
            pg8::gemm_phase<pg8::EpiB16WT, pg8::StaticOrder, true, true>(lds, g, S, E); \
            if (FUSE_NORM) { pg8::Unit u0; if (S.next(0, u0)) { panel_wait((unsigned*)(ctl + CW_CNT0) + ((2 * l) * 32 + u0.pm) * 16, tid); \
                const __amdgpu_buffer_rsrc_t rm = __builtin_amdgcn_make_buffer_rsrc((void*)MIXB, (short)0, 0x7fffffff, 0x00020000); \
                _Pragma("unroll") for (int i = 0; i < 2; ++i) { const size_t m = (size_t)u0.pm * 256 + u0.pn * 32 + wave * 4 + 2 * i; bf16* xo = XB + m * DM; bf16* ho = H + m * DM; \
                    if (l == 0) norm_res_row2_sc1<false>(rm, m, x_prompt + m * DM, (size_t)DM * 4, norm_mix_post + l * DM, xo, nullptr, norm_ffn_pre + l * DM, ho, lane); \
                    else norm_res_row2_sc1<true>(rm, m, xo, (size_t)DM * 2, norm_mix_post + l * DM, xo, nullptr, norm_ffn_pre + l * DM, ho, lane); } } } \
            int nsu = 0; \
            for (int su = bid; su < DM / 64; su += G) { ++nsu; \
                pg8::SEpiF32WT SE{MIXS, DM, 64 * su}; \
                pg8::gemm_small_unit(lds, MIXIN + (size_t)MP * DM, DM, Wout_t + (size_t)l * DM * DM, DM, 0, DM / 64, pg8::BRowLin{64 * su}, SE); } \
            if (G == 256 && bid >= DM / 64) {      \
                asm volatile("s_waitcnt vmcnt(0) lgkmcnt(0)" ::: "memory"); __syncthreads(); \
                convert_layer(WP, l, (bid - DM / 64) * NWAVES + wave, (G - DM / 64) * NWAVES, (LAS float*)(lds + wave * 16384), lane, 6); \
                if (l + 1 < DEPTH) convert_layer(WP, l + 1, (bid - DM / 64) * NWAVES + wave, (G - DM / 64) * NWAVES, (LAS float*)(lds + wave * 16384), lane, 10); } \
            {   unsigned* sc = (unsigned*)(ctl + CW_CNT0) + (256 + 2 * l) * 16; \
                sample_count(sc, nsu, tid); \
                if (bid >= G - 16) { sample_wait(sc, DM / 64, tid); \
                    const int m = MP + 8 * (bid - (G - 16)) + wave; bf16* xo = XB + (size_t)m * DM; bf16* ho = H + (size_t)m * DM; \
                    const __amdgpu_buffer_rsrc_t rs = __builtin_amdgcn_make_buffer_rsrc((void*)MIXS, (short)0, 0x7fffffff, 0x00020000); \
                    if (l == 0) norm_res_row_s<false>(rs, (size_t)(m - MP) * DM * 4, 1, 0, x_sample + (size_t)(m - MP) * DM, norm_mix_post + l * DM, xo, nullptr, norm_ffn_pre + l * DM, ho, lane); \
                    else norm_res_row_s<true>(rs, (size_t)(m - MP) * DM * 4, 1, 0, xo, norm_mix_post + l * DM, xo, nullptr, norm_ffn_pre + l * DM, ho, lane); } } } \
        } \
        SEAM(pb + 2); \
        if (IN(pb + 3)) { \
            { pg8::Gemm g{H, Wgu_t + (size_t)l * 2 * DFF * DM, MP, 2 * DFF, DM}; pg8::StaticOrder S; S.init(MP, 2 * DFF, G, bid); \
            pg8::EpiGU E{ACT, DFF}; \
            pg8::gemm_phase<pg8::EpiGU, pg8::StaticOrder, true, true>(lds, g, S, E); \
            if (DUP_GEMM & 2) pg8::gemm_phase<pg8::EpiGU, pg8::StaticOrder, true, true>(lds, g, S, E); \
            if (bid >= G / 2) for (int su = bid - G / 2; su < DFF / 32; su += G - G / 2) {      \
                pg8::SEpiGU SE{ACT + (size_t)MP * DFF, DFF, 32 * su}; \
                pg8::gemm_small_unit(lds, H + (size_t)MP * DM, DM, Wgu_t + (size_t)l * 2 * DFF * DM, DM, 0, DM / 64, pg8::BRowGU{su >> 2, su & 3}, SE); } } \
            if (l + 1 < DEPTH && bid >= G / 2) {      \
                asm volatile("s_waitcnt vmcnt(0) lgkmcnt(0)" ::: "memory"); __syncthreads(); \
                if (G == 256) { const int b2 = bid - 128;      \
                    if (b2 >= 48 || wave < 5) convert_layer(WP, l + 1, b2 < 48 ? b2 * 5 + wave : 240 + (b2 - 48) * 8 + wave, 880, (LAS float*)(lds + wave * 16384), lane, 11); } \
                if (DUP_CONV) convert_layer(WP, l + 1, (bid - G / 2) * NWAVES + wave, (G - G / 2) * NWAVES, (LAS float*)(lds + wave * 16384), lane, 2); } \
        } \
        SEAM(pb + 3); \
        if (IN(pb + 4)) { \
            { pg8::Gemm g{ACT, Wdn_t + (size_t)l * DM * DFF, MP, DM, DFF}; pg8::StaticOrder S; S.init(MP, DM, G, bid); \
            pg8::EpiB16WT E{MIXB, DM}; \
            pg8::gemm_phase<pg8::EpiB16WT, pg8::StaticOrder, true, true>(lds, g, S, E); \
            if (FUSE_NORM) { pg8::Unit u0; if (S.next(0, u0)) { panel_wait((unsigned*)(ctl + CW_CNT0) + ((2 * l + 1) * 32 + u0.pm) * 16, tid); \
                const __amdgpu_buffer_rsrc_t rm = __builtin_amdgcn_make_buffer_rsrc((void*)MIXB, (short)0, 0x7fffffff, 0x00020000); \
                const bool last = (l == DEPTH - 1); const float* gp = last ? nullptr : norm_mix_pre + (l + 1) * DM; \
                _Pragma("unroll") for (int i = 0; i < 2; ++i) { const size_t m = (size_t)u0.pm * 256 + u0.pn * 32 + wave * 4 + 2 * i; bf16* xo = XB + m * DM; \
                    norm_res_row2_sc1<true>(rm, m, xo, (size_t)DM * 2, norm_ffn_post + l * DM, last ? nullptr : xo, last ? args.out + OUT_Y + m * DM : nullptr, gp, last ? nullptr : H + m * DM, lane); } } } \
            int nsu = 0; \
            for (int su = bid; su < 4 * (DM / 64); su += G) { ++nsu;      \
                const int ks = su & 3, nt = su >> 2; \
                pg8::SEpiF32WT SE{MIXS + (size_t)ks * MS * DM, DM, 64 * nt}; \
                pg8::gemm_small_unit(lds, ACT + (size_t)MP * DFF, DFF, Wdn_t + (size_t)l * DM * DFF, DFF, ks * (DFF / 4), DFF / 4 / 64, pg8::BRowLin{64 * nt}, SE); } \
            {   unsigned* sc = (unsigned*)(ctl + CW_CNT0) + (256 + 2 * l + 1) * 16; \
                sample_count(sc, nsu, tid); \
                if (bid >= G - 16) { sample_wait(sc, 4 * (DM / 64), tid); \
                    const bool last = (l == DEPTH - 1); \
                    const int m = MP + 8 * (bid - (G - 16)) + wave; bf16* xo = XB + (size_t)m * DM; \
                    const __amdgpu_buffer_rsrc_t rs = __builtin_amdgcn_make_buffer_rsrc((void*)MIXS, (short)0, 0x7fffffff, 0x00020000); \
                    norm_res_row_s<true>(rs, (size_t)(m - MP) * DM * 4, 4, (size_t)MS * DM * 4, xo, norm_ffn_post + l * DM, last ? nullptr : xo, last ? args.out + OUT_Y + (size_t)m * DM : nullptr, \
                                         last ? nullptr : norm_mix_pre + (l + 1) * DM, last ? nullptr : H + (size_t)m * DM, lane); } } } \
        } \
        SEAM(pb + 4); \
    } while (0)
struct Args { const float* in[18]; float* out; unsigned char* ws; int ph_lo, ph_hi; };
constexpr int NPHASE = 1 + 5 * DEPTH;
__global__ void __launch_bounds__(NWAVES * 64, 2) mk_fwd(Args args) {
    extern __shared__ __attribute__((aligned(16))) unsigned char lds_raw[];
    LAS unsigned char* lds = (LAS unsigned char*)lds_raw;
    volatile LAS unsigned* MISC = (volatile LAS unsigned*)(lds + MISC_OFF);
    const int tid = threadIdx.x, lane = tid & 63, wave = __builtin_amdgcn_readfirstlane(tid >> 6);
    const int G = gridDim.x, bid = blockIdx.x;
    unsigned char* ws = args.ws;
    gu32* ctl = (gu32*)(ws + WS_CTL);
    for (int u = tid; u < (LDS_BYTES - LDSCTL_OFF) / 4; u += NWAVES * 64) ((LAS unsigned*)(lds + LDSCTL_OFF))[u] = 0u;
    __syncthreads();
#if MK_MULTI
    XcdBarrier bar; bar.bar = (unsigned*)(ctl + CW_BAR); bar.x = 0; bar.st = nullptr;
#define GRID_BAR() do { } while (0)
#else
    XcdBarrier bar = xcd_barrier_post((unsigned*)(ctl + CW_BAR), MISC + 8);
#define GRID_BAR() xcd_barrier(bar)
#endif
    const int lo = args.ph_lo, hi = args.ph_hi;
#define IN(k) (lo <= (k) && (k) < hi)
#define SEAM(k) do { if (IN(k) && IN((k) + 1)) GRID_BAR(); } while (0)
    const float* x_prompt = args.in[0]; const float* x_sample = args.in[1]; const float* state_hgrn = args.in[2];
    const float* norm_mix_pre = args.in[3]; const float* norm_mix_post = args.in[4]; const float* w_in = args.in[5];
    const float* ln_v_gain = args.in[6]; const float* ln_v_bias = args.in[7]; const float* spatial_w = args.in[8]; const float* spatial_b = args.in[9];
    const float* lb_param = args.in[10]; const float* hgrn_out_gain = args.in[11]; const float* w_out = args.in[12];
    const float* norm_ffn_pre = args.in[13]; const float* norm_ffn_post = args.in[14]; const float* w_gate = args.in[15]; const float* w_up = args.in[16]; const float* w_down = args.in[17];
    bf16* Win_t = (bf16*)(ws + WS_WIN); bf16* Wout_t = (bf16*)(ws + WS_WOUT); bf16* Wgu_t = (bf16*)(ws + WS_WGU); bf16* Wdn_t = (bf16*)(ws + WS_WDN);
    bf16* XB = (bf16*)(ws + WS_X); bf16* MIXB = (bf16*)(ws + WS_MIX); bf16* H = (bf16*)(ws + WS_H); bf16* PROJ = (bf16*)(ws + WS_PROJ); float* ZF = (float*)(ws + WS_ZF);
    bf16* MIXIN = (bf16*)(ws + WS_MIXIN); bf16* ACT = (bf16*)(ws + WS_ACT); float* LB = (float*)(ws + WS_LB); float* MIXS = (float*)(ws + WS_MIXS);
    bf16* HQF = (bf16*)(ws + WS_HQF); bf16* HKET = (bf16*)(ws + WS_HKET); bf16* HIT = (bf16*)(ws + WS_HIT); bf16* HOI = (bf16*)(ws + WS_HOI); float* HDL = (float*)(ws + WS_HDL);
    const int gw = bid * NWAVES + wave, NGW = G * NWAVES;
    WPtrs WP; WP.w_in = w_in; WP.w_out = w_out; WP.w_gate = w_gate; WP.w_up = w_up; WP.w_down = w_down; WP.Win_t = Win_t; WP.Wout_t = Wout_t; WP.Wgu_t = Wgu_t; WP.Wdn_t = Wdn_t;

    if (IN(0)) {
        if (G == 256) convert_layer(WP, 0, gw, NGW, (LAS float*)(lds + wave * 16384), lane, 1);
        else for (int ll = 0; ll < DEPTH; ++ll) convert_layer(WP, ll, gw, NGW, (LAS float*)(lds + wave * 16384), lane, 0);
        for (int c = bid * 512 + tid; c < 1024; c += G * 512) {
            const float a0 = lb_param[c], a1 = lb_param[1024 + c], a2 = lb_param[2048 + c], a3 = lb_param[3072 + c];
            const float mx = fmaxf(fmaxf(a0, a1), fmaxf(a2, a3));
            const float e0 = expf(a0 - mx), e1 = expf(a1 - mx), e2 = expf(a2 - mx), e3 = expf(a3 - mx); const float inv = 1.0f / (e0 + e1 + e2 + e3);
            LB[c] = 0.f; LB[1024 + c] = e1 * inv; LB[2048 + c] = (e1 + e2) * inv; LB[3072 + c] = (e1 + e2 + e3) * inv;
        }
        for (int m = gw; m < MREAL; m += NGW) { const float* xr = (m < MP) ? x_prompt + (size_t)m * DM : x_sample + (size_t)(m - MP) * DM; norm_in_row(xr, norm_mix_pre, H + (size_t)m * DM, lane); }
    }
    SEAM(0);
    LAYER_BODY(0); LAYER_BODY(1); LAYER_BODY(2); LAYER_BODY(3);
#undef IN
#undef SEAM
}

extern "C" void kernel_launch(void* const* d_in, const int* in_sizes, int n_in, void* d_out, int out_size, void* d_ws, size_t ws_size, hipStream_t stream) {
    static int grid = 0;
    if (grid == 0) {
        if (n_in != 18 || (size_t)out_size != OUT_TOTAL || ws_size < WS_END) { fprintf(stderr, "kernel_launch: unexpected shapes (n_in %d out %d ws %zu)\n", n_in, out_size, ws_size); grid = -1; return; }
        int dev = 0, cus = 0, per_cu = 0;
        if (hipGetDevice(&dev) != hipSuccess || hipDeviceGetAttribute(&cus, hipDeviceAttributeMultiprocessorCount, dev) != hipSuccess) { grid = -1; return; }
        if (hipFuncSetAttribute((const void*)mk_fwd, hipFuncAttributeMaxDynamicSharedMemorySize, LDS_BYTES) != hipSuccess) { grid = -1; return; }
        if (hipOccupancyMaxActiveBlocksPerMultiprocessor(&per_cu, (const void*)mk_fwd, NWAVES * 64, LDS_BYTES) != hipSuccess || per_cu < 1) { fprintf(stderr, "kernel_launch: occupancy query says %d\n", per_cu); }
        (void)hipGetLastError();
        grid = cus;
    }
    if (grid < 0) return;
    (void)hipMemsetAsync((char*)d_ws + WS_CTL, 0, CTL_ZERO_BYTES, stream);
    Args a{};
    for (int i = 0; i < 18; ++i) a.in[i] = (const float*)d_in[i];
    a.out = (float*)d_out; a.ws = (unsigned char*)d_ws;
#if MK_MULTI
    for (int p = 0; p < NPHASE; ++p) { a.ph_lo = p; a.ph_hi = p + 1; hipLaunchKernelGGL(mk_fwd, dim3(grid), dim3(NWAVES * 64), LDS_BYTES, stream, a); }
#else
    a.ph_lo = 0; a.ph_hi = NPHASE;
    hipLaunchKernelGGL(mk_fwd, dim3(grid), dim3(NWAVES * 64), LDS_BYTES, stream, a);
#endif
}
```

```cpp
#include <hip/hip_runtime.h>
#include <cstdio>
#include <cstdint>
namespace pg8 {
#define PG8_LAS __attribute__((address_space(3)))
typedef unsigned short bf16_t;
typedef short bf16x8 __attribute__((ext_vector_type(8)));
typedef float f32x4 __attribute__((ext_vector_type(4)));
typedef unsigned u32x4 __attribute__((ext_vector_type(4)));
constexpr int BM = 256, BK = 64, HALF = 128, HTB = HALF * BK * 2  , STAGE_BYTES = 8 * HTB, NXCD = 8, WGM = 8;

__host__ __device__ __forceinline__ int lds_byte(int r, int c) { const int st = (r >> 4) * 2 + (c >> 5), rr = r & 15, cc = c & 31, ob = rr * 64 + cc * 2; return st * 1024 + (ob ^ (((ob >> 9) & 1) << 5)); }
__host__ __device__ __forceinline__ void stage_rc(int b, int& R, int& C) { const int st = b / 1024, sb = b % 1024, swz = sb ^ (((sb >> 9) & 1) << 5); R = (st >> 1) * 16 + swz / 64; C = (st & 1) * 32 + (swz % 64) / 2; }
__host__ __device__ __forceinline__ int perm32(int rho) { const int n = rho >> 4, i = rho & 15; return 8 * (i >> 2) + 4 * n + (i & 3); }

struct Unit { int pm, pn; };
struct Gemm { const bf16_t* A; const bf16_t* Bt; int M, N, K; };

struct StaticOrder {
    int nM, nN, nwg, G, c;
    __host__ __device__ void init(int M, int N, int G_, int c_) { nM = M / BM; nN = N / BM; nwg = nM * nN; G = G_; c = c_; }
    __host__ __device__ __forceinline__ bool next(int i, Unit& u) const {
        const long L = (long)i * G + c; if (L >= nwg) return false;
        int wgid = (int)L; { const int q = nwg / NXCD, r = nwg % NXCD, xcd = wgid % NXCD, off = wgid / NXCD; wgid = (xcd < r ? xcd * (q + 1) : r * (q + 1) + (xcd - r) * q) + off; }
        const int nig = WGM * nN, gid = wgid / nig, fm = gid * WGM, gsz = (nM - fm) < WGM ? (nM - fm) : WGM;
        u.pm = fm + ((wgid % nig) % gsz); u.pn = (wgid % nig) / gsz; return true;
    }
    __device__ __forceinline__ void a_ready(const Unit&) const {}
    __device__ __forceinline__ void done(const Unit&) const {}
};

typedef float f32x2c_t __attribute__((ext_vector_type(2))); typedef __bf16 bf16x2c_t __attribute__((ext_vector_type(2)));
__device__ __forceinline__ unsigned cvt_pk_bf16(float lo, float hi) { f32x2c_t v = {lo, hi}; bf16x2c_t b = __builtin_convertvector(v, bf16x2c_t); return __builtin_bit_cast(unsigned, b); }
typedef float f32x2 __attribute__((ext_vector_type(2)));
__device__ __forceinline__ f32x2 gelu_pk(f32x2 v) {
    const f32x2 av = __builtin_elementwise_abs(v), d = av * 0.2316418882f + 1.0f;
    f32x2 t; t.x = __builtin_amdgcn_rcpf(d.x); t.y = __builtin_amdgcn_rcpf(d.y);
    f32x2 q = t * 0.5307027145f + (-0.7265760135f); q = q * t + 0.7107068705f; q = q * t + (-0.142248368f); q = q * t + 0.127414796f; q = q * t;
    const f32x2 s = (v * v) * (-0.72134752044f);
    f32x2 e; e.x = __builtin_amdgcn_exp2f(s.x); e.y = __builtin_amdgcn_exp2f(s.y);
    const f32x2 m = v * (q * e), r = v - m;
    f32x2 o; o.x = v.x < 0.f ? m.x : r.x; o.y = v.y < 0.f ? m.y : r.y; return o;
}
__device__ __forceinline__ float silu_f(float x) { return x * __builtin_amdgcn_rcpf(1.0f + __expf(-x)); }
struct EpiIn {
    static constexpr bool PERM = true, AFTER_DRAIN = false;
    bf16_t* P; float* ZF;
    __device__ __forceinline__ void operator()(const f32x4 (&acc)[2][2][4][2], const Unit& u, int wr, int wc, int fr, int fq) const {
        const int typ = u.pn >> 2;
        const int row0 = u.pm * BM + wr * 64 + fr, col0 = u.pn * BM + wc * 32 + 8 * fq;
        if (typ == 3) {
#pragma unroll
            for (int ai = 0; ai < 2; ++ai)
#pragma unroll
                for (int m = 0; m < 4; ++m) { float* rowp = ZF + (size_t)(row0 + ai * HALF + m * 16) * 1024 + (col0 - 3072);
#pragma unroll
                    for (int bj = 0; bj < 2; ++bj) { *(f32x4*)(rowp + bj * HALF) = acc[ai][bj][m][0]; *(f32x4*)(rowp + bj * HALF + 4) = acc[ai][bj][m][1]; } }
        } else {
#pragma unroll
            for (int ai = 0; ai < 2; ++ai)
#pragma unroll
                for (int m = 0; m < 4; ++m) { bf16_t* rowp = P + (size_t)(row0 + ai * HALF + m * 16) * 6144 + col0;
#pragma unroll
                    for (int bj = 0; bj < 2; ++bj) { f32x4 v0 = acc[ai][bj][m][0], v1 = acc[ai][bj][m][1];
                        if (typ <= 1) { f32x2 a = gelu_pk((f32x2){v0[0], v0[1]}), b = gelu_pk((f32x2){v0[2], v0[3]}), c = gelu_pk((f32x2){v1[0], v1[1]}), d = gelu_pk((f32x2){v1[2], v1[3]});
                            v0 = (f32x4){a.x, a.y, b.x, b.y}; v1 = (f32x4){c.x, c.y, d.x, d.y}; }
                        else if (typ != 4) { v0 = (f32x4){silu_f(v0[0]), silu_f(v0[1]), silu_f(v0[2]), silu_f(v0[3])}; v1 = (f32x4){silu_f(v1[0]), silu_f(v1[1]), silu_f(v1[2]), silu_f(v1[3])}; }
                        u32x4 w; w.x = cvt_pk_bf16(v0[0], v0[1]); w.y = cvt_pk_bf16(v0[2], v0[3]); w.z = cvt_pk_bf16(v1[0], v1[1]); w.w = cvt_pk_bf16(v1[2], v1[3]);
                        *(u32x4*)(rowp + bj * HALF) = w; } }
        }
    }
};
struct EpiF32 {
    static constexpr bool PERM = false, AFTER_DRAIN = false;
    float* O; int ldc;
    __device__ __forceinline__ void operator()(const f32x4 (&acc)[2][2][4][2], const Unit& u, int wr, int wc, int fr, int fq) const {
        const int row0 = u.pm * BM + wr * 64 + fr, col0 = u.pn * BM + wc * 32 + 4 * fq;
#pragma unroll
        for (int ai = 0; ai < 2; ++ai)
#pragma unroll
            for (int m = 0; m < 4; ++m) { float* rowp = O + (size_t)(row0 + ai * HALF + m * 16) * ldc + col0;
#pragma unroll
                for (int bj = 0; bj < 2; ++bj)
#pragma unroll
                    for (int n = 0; n < 2; ++n) *(f32x4*)(rowp + bj * HALF + n * 16) = acc[ai][bj][m][n]; }
    }
};
struct EpiGU {
    static constexpr bool PERM = true, AFTER_DRAIN = false;
    bf16_t* O; int ldc;
    __device__ __forceinline__ void operator()(const f32x4 (&acc)[2][2][4][2], const Unit& u, int wr, int wc, int fr, int fq) const {
        const int row0 = u.pm * BM + wr * 64 + fr, col0 = u.pn * HALF + wc * 32 + 8 * fq;
#pragma unroll
        for (int ai = 0; ai < 2; ++ai)
#pragma unroll
            for (int m = 0; m < 4; ++m) { bf16_t* rowp = O + (size_t)(row0 + ai * HALF + m * 16) * ldc + col0;
                const f32x4 g0 = acc[ai][0][m][0], g1 = acc[ai][0][m][1], u0 = acc[ai][1][m][0], u1 = acc[ai][1][m][1];
                u32x4 w; w.x = cvt_pk_bf16(silu_f(g0[0]) * u0[0], silu_f(g0[1]) * u0[1]); w.y = cvt_pk_bf16(silu_f(g0[2]) * u0[2], silu_f(g0[3]) * u0[3]);
                w.z = cvt_pk_bf16(silu_f(g1[0]) * u1[0], silu_f(g1[1]) * u1[1]); w.w = cvt_pk_bf16(silu_f(g1[2]) * u1[2], silu_f(g1[3]) * u1[3]);
                *(u32x4*)rowp = w; }
    }
};
struct EpiB16 {
    static constexpr bool PERM = true, AFTER_DRAIN = false;
    bf16_t* O; int ldc;
    __device__ __forceinline__ void operator()(const f32x4 (&acc)[2][2][4][2], const Unit& u, int wr, int wc, int fr, int fq) const {
        const int row0 = u.pm * BM + wr * 64 + fr, col0 = u.pn * BM + wc * 32 + 8 * fq;
#pragma unroll
        for (int ai = 0; ai < 2; ++ai)
#pragma unroll
            for (int m = 0; m < 4; ++m) { bf16_t* rowp = O + (size_t)(row0 + ai * HALF + m * 16) * ldc + col0;
#pragma unroll
                for (int bj = 0; bj < 2; ++bj) { const f32x4 v0 = acc[ai][bj][m][0], v1 = acc[ai][bj][m][1];
                    u32x4 w; w.x = cvt_pk_bf16(v0[0], v0[1]); w.y = cvt_pk_bf16(v0[2], v0[3]); w.z = cvt_pk_bf16(v1[0], v1[1]); w.w = cvt_pk_bf16(v1[2], v1[3]);
                    *(u32x4*)(rowp + bj * HALF) = w; } }
    }
};
struct EpiB16WT {
    static constexpr bool PERM = true, AFTER_DRAIN = false;
    bf16_t* O; int ldc;
    __device__ __forceinline__ void operator()(const f32x4 (&acc)[2][2][4][2], const Unit& u, int wr, int wc, int fr, int fq) const {
        const int row0 = u.pm * BM + wr * 64 + fr, col0 = u.pn * BM + wc * 32 + 8 * fq;
        const __amdgpu_buffer_rsrc_t r = __builtin_amdgcn_make_buffer_rsrc((void*)O, (short)0, 0x7fffffff, 0x00020000);
#pragma unroll
        for (int ai = 0; ai < 2; ++ai)
#pragma unroll
            for (int m = 0; m < 4; ++m) { const size_t ro = ((size_t)(row0 + ai * HALF + m * 16) * ldc + col0) * 2;
#pragma unroll
                for (int bj = 0; bj < 2; ++bj) { const f32x4 v0 = acc[ai][bj][m][0], v1 = acc[ai][bj][m][1];
                    u32x4 w; w.x = cvt_pk_bf16(v0[0], v0[1]); w.y = cvt_pk_bf16(v0[2], v0[3]); w.z = cvt_pk_bf16(v1[0], v1[1]); w.w = cvt_pk_bf16(v1[2], v1[3]);
                    __builtin_amdgcn_raw_buffer_store_b128(w, r, (unsigned)(ro + bj * HALF * 2), 0, 16); } }
    }
};
template <class Epi, class Sched, bool ALIGN_EPI = false, bool SP2 = false>
__device__ __forceinline__ void gemm_phase(PG8_LAS unsigned char* lds, const Gemm g, const Sched& S, const Epi& E) {
    const int tid = threadIdx.x, wid = __builtin_amdgcn_readfirstlane(tid >> 6), lane = tid & 63, wr = wid >> 2, wc = wid & 3, fr = lane & 15, fq = lane >> 4;
    const int K = g.K, nt = K / BK;
    unsigned voffA[2], voffB[2];
#pragma unroll
    for (int i = 0; i < 2; ++i) { int R, C; stage_rc(tid * 16 + i * 8192, R, C); const int Rb = Epi::PERM ? ((R & ~31) + perm32(R & 31)) : R;
        voffA[i] = (unsigned)(R * K + C) * 2u; voffB[i] = (unsigned)(Rb * K + C) * 2u; }
    const size_t kstep = (size_t)(BK * 2);
    const size_t hstep = (size_t)HALF * K * 2;
    const size_t tstep = 2 * hstep;
    const unsigned ldsw = (unsigned)wid * 1024u;
    const int aoff = lds_byte(wr * 64 + fr, fq * 8), boff = lds_byte(wc * 32 + fr, fq * 8);
#define PG8_SA(b, h) (((b) * 2 + (h)) * HTB)
#define PG8_SB(b, h) ((4 + (b) * 2 + (h)) * HTB)
#define PG8_STAGE(bufoff, gbase, voff) do { _Pragma("unroll") for (int _i = 0; _i < 2; ++_i) \
        __builtin_amdgcn_global_load_lds((const unsigned*)((const char*)(gbase) + (voff)[_i]), (PG8_LAS unsigned*)(lds + (bufoff) + ldsw + _i * 8192), 16, 0, 0); } while (0)
#define PG8_LDA(dst, b, h) do { _Pragma("unroll") for (int m = 0; m < 4; ++m) _Pragma("unroll") for (int k = 0; k < 2; ++k) dst[m][k] = *(const PG8_LAS bf16x8*)(lds + PG8_SA(b, h) + aoff + m * 2048 + k * 1024); } while (0)
#define PG8_LDB(dst, b, h) do { _Pragma("unroll") for (int n = 0; n < 2; ++n) _Pragma("unroll") for (int k = 0; k < 2; ++k) dst[n][k] = *(const PG8_LAS bf16x8*)(lds + PG8_SB(b, h) + boff + n * 2048 + k * 1024); } while (0)
#define PG8_MMA(ai, bj, At, Bt) do { __builtin_amdgcn_s_setprio(1); _Pragma("unroll") for (int m = 0; m < 4; ++m) _Pragma("unroll") for (int n = 0; n < 2; ++n) _Pragma("unroll") for (int k = 0; k < 2; ++k) \
        acc[ai][bj][m][n] = __builtin_amdgcn_mfma_f32_16x16x32_bf16(Bt[n][k], At[m][k], acc[ai][bj][m][n], 0, 0, 0); __builtin_amdgcn_s_setprio(0); } while (0)
#define PG8_WAIT_V(n) asm volatile("s_waitcnt vmcnt(" #n ")" ::: "memory")
#define PG8_WAIT_L(n) asm volatile("s_waitcnt lgkmcnt(" #n ")" ::: "memory")
#define PG8_BAR __builtin_amdgcn_s_barrier()
#define PG8_SCHED __builtin_amdgcn_sched_barrier(0)
    Unit cur, nxt; int ui = 0;
    if (!S.next(0, cur)) return;
    f32x4 acc[2][2][4][2];
#pragma unroll
    for (int a = 0; a < 2; ++a)
#pragma unroll
        for (int b = 0; b < 2; ++b)
#pragma unroll
            for (int m = 0; m < 4; ++m)
#pragma unroll
                for (int n = 0; n < 2; ++n) acc[a][b][m][n] = (f32x4){0.f, 0.f, 0.f, 0.f};
    bf16x8 At[4][2], B0[2][2], B1[2][2];
    const char* cA = (const char*)g.A + (size_t)cur.pm * tstep; const char* cB = (const char*)g.Bt + (size_t)cur.pn * tstep;
    S.a_ready(cur);
    if constexpr (SP2) {
        PG8_STAGE(PG8_SB(0, 0), cB, voffB); PG8_STAGE(PG8_SB(0, 1), cB + hstep, voffB); PG8_STAGE(PG8_SA(0, 0), cA, voffA); PG8_STAGE(PG8_SA(0, 1), cA + hstep, voffA);
        if (wr == 1) PG8_BAR;
        PG8_WAIT_V(2); PG8_BAR;
        PG8_STAGE(PG8_SB(1, 0), cB + kstep, voffB); PG8_STAGE(PG8_SA(1, 0), cA + kstep, voffA); PG8_STAGE(PG8_SB(1, 1), cB + hstep + kstep, voffB);
        PG8_WAIT_V(6); PG8_BAR;
    } else {
        PG8_STAGE(PG8_SB(0, 0), cB, voffB); PG8_STAGE(PG8_SA(0, 0), cA, voffA); PG8_STAGE(PG8_SB(0, 1), cB + hstep, voffB); PG8_STAGE(PG8_SA(0, 1), cA + hstep, voffA);
        if (wr == 1) PG8_BAR;
        PG8_WAIT_V(4); PG8_BAR;
        PG8_STAGE(PG8_SB(1, 0), cB + kstep, voffB); PG8_STAGE(PG8_SA(1, 0), cA + kstep, voffA); PG8_STAGE(PG8_SB(1, 1), cB + hstep + kstep, voffB);
        PG8_WAIT_V(6); PG8_BAR;
    }
    for (;;) {
        const bool has_next = S.next(ui + 1, nxt);
        const char* nA = has_next ? (const char*)g.A + (size_t)nxt.pm * tstep : cA; const char* nB = has_next ? (const char*)g.Bt + (size_t)nxt.pn * tstep : cB;
        for (int t = 0; t < nt; t += 2) {
            const bool last = (t == nt - 2);
            const char* a1 = cA + (size_t)(t + 1) * kstep;
            const char* a2 = last ? nA : cA + (size_t)(t + 2) * kstep; const char* b2 = last ? nB : cB + (size_t)(t + 2) * kstep;
            const char* a3 = a2 + kstep; const char* b3 = b2 + kstep;
            if (last && has_next) S.a_ready(nxt);
            if constexpr (SP2) {
            PG8_LDB(B0, 0, 0); PG8_LDB(B1, 0, 1); PG8_SCHED; PG8_LDA(At, 0, 0); PG8_STAGE(PG8_SA(1, 1), a1 + hstep, voffA);
            PG8_WAIT_V(8); PG8_WAIT_L(0); PG8_BAR; PG8_MMA(0, 0, At, B0); PG8_MMA(0, 1, At, B1); PG8_BAR; PG8_SCHED;
            PG8_LDA(At, 0, 1); PG8_STAGE(PG8_SB(0, 0), b2, voffB); PG8_STAGE(PG8_SB(0, 1), b2 + hstep, voffB); PG8_STAGE(PG8_SA(0, 0), a2, voffA);
            PG8_WAIT_V(8); PG8_WAIT_L(0); PG8_BAR; PG8_MMA(1, 0, At, B0); PG8_MMA(1, 1, At, B1); PG8_BAR; PG8_SCHED;
            PG8_LDB(B0, 1, 0); PG8_LDB(B1, 1, 1); PG8_SCHED; PG8_LDA(At, 1, 0); PG8_STAGE(PG8_SA(0, 1), a2 + hstep, voffA);
            PG8_WAIT_V(8); PG8_WAIT_L(0); PG8_BAR; PG8_MMA(0, 0, At, B0); PG8_MMA(0, 1, At, B1); PG8_BAR; PG8_SCHED;
            PG8_LDA(At, 1, 1); PG8_STAGE(PG8_SB(1, 0), b3, voffB); PG8_STAGE(PG8_SB(1, 1), b3 + hstep, voffB); PG8_STAGE(PG8_SA(1, 0), a3, voffA);
            PG8_WAIT_V(8); PG8_WAIT_L(0); PG8_BAR; PG8_MMA(1, 0, At, B0); PG8_MMA(1, 1, At, B1); PG8_BAR; PG8_SCHED;
            } else {
            PG8_LDB(B0, 0, 0); PG8_SCHED; PG8_LDA(At, 0, 0); PG8_STAGE(PG8_SA(1, 1), a1 + hstep, voffA);
            PG8_WAIT_L(8); PG8_BAR; PG8_WAIT_L(0); PG8_MMA(0, 0, At, B0); PG8_BAR; PG8_SCHED;
            PG8_LDB(B1, 0, 1); PG8_STAGE(PG8_SB(0, 0), b2, voffB);
            PG8_BAR; PG8_WAIT_L(0); PG8_MMA(0, 1, At, B1); PG8_BAR;
            PG8_LDA(At, 0, 1); PG8_STAGE(PG8_SA(0, 0), a2, voffA);
            PG8_BAR; PG8_WAIT_L(0); PG8_MMA(1, 0, At, B0); PG8_BAR; PG8_SCHED;
            PG8_STAGE(PG8_SB(0, 1), b2 + hstep, voffB);
            PG8_WAIT_V(6); PG8_BAR; PG8_MMA(1, 1, At, B1); PG8_BAR;
            PG8_LDB(B0, 1, 0); PG8_SCHED; PG8_LDA(At, 1, 0); PG8_STAGE(PG8_SA(0, 1), a2 + hstep, voffA);
            PG8_WAIT_L(8); PG8_BAR; PG8_WAIT_L(0); PG8_MMA(0, 0, At, B0); PG8_BAR; PG8_SCHED;
            PG8_LDB(B1, 1, 1); PG8_STAGE(PG8_SB(1, 0), b3, voffB);
            PG8_BAR; PG8_WAIT_L(0); PG8_MMA(0, 1, At, B1); PG8_BAR;
            PG8_LDA(At, 1, 1); PG8_STAGE(PG8_SA(1, 0), a3, voffA);
            PG8_BAR; PG8_WAIT_L(0); PG8_MMA(1, 0, At, B0); PG8_BAR; PG8_SCHED;
            PG8_STAGE(PG8_SB(1, 1), b3 + hstep, voffB);
            PG8_WAIT_V(6); PG8_BAR; PG8_MMA(1, 1, At, B1); PG8_BAR;
            }
        }
        if constexpr (ALIGN_EPI) { if (wr == 0) PG8_BAR; }
        if constexpr (!Epi::AFTER_DRAIN) { E(acc, cur, wr, wc, fr, fq); S.done(cur); }
        if (!has_next) break;
#pragma unroll
        for (int a = 0; a < 2; ++a)
#pragma unroll
            for (int b = 0; b < 2; ++b)
#pragma unroll
                for (int m = 0; m < 4; ++m)
#pragma unroll
                    for (int n = 0; n < 2; ++n) acc[a][b][m][n] = (f32x4){0.f, 0.f, 0.f, 0.f};
        cur = nxt; cA = nA; cB = nB; ++ui;
        if constexpr (ALIGN_EPI) { if (wr == 1) PG8_BAR; }
    }
    PG8_WAIT_V(0);
    if constexpr (!ALIGN_EPI) { if (wr == 0) PG8_BAR; }
    PG8_BAR;
    if constexpr (Epi::AFTER_DRAIN) { E.fused(acc, cur, wr, wc, fr, fq, lds, wid, lane); S.done(cur); }
#undef PG8_SA
#undef PG8_SB
#undef PG8_STAGE
#undef PG8_LDA
#undef PG8_LDB
#undef PG8_MMA
#undef PG8_WAIT_V
#undef PG8_WAIT_L
#undef PG8_BAR
#undef PG8_SCHED
}
template <class BRow, class Epi>
__device__ __forceinline__ void gemm_small_unit(PG8_LAS unsigned char* lds, const bf16_t* A, int lda, const bf16_t* Bt, int ldb, int k0, int nkt, const BRow& brow, const Epi& E) {
    const int tid = threadIdx.x, wid = __builtin_amdgcn_readfirstlane(tid >> 6), lane = tid & 63, fr = lane & 15, fq = lane >> 4;
    constexpr int SLOT = 24576;
    const char* sA0; const char* sA1; const char* sB;
    { int R, C; stage_rc(tid * 16, R, C); sA0 = (const char*)(A + (size_t)R * lda + k0 + C); sB = (const char*)(Bt + (size_t)brow(R) * ldb + k0 + C);
      stage_rc(tid * 16 + 8192, R, C); sA1 = (const char*)(A + (size_t)R * lda + k0 + C); }
    const unsigned ldsw = (unsigned)wid * 1024u;
    const int foff = lds_byte(fr, fq * 8);
#define SM_STAGE(t) do { const int _b = ((t) & 3) * SLOT; const size_t _ko = (size_t)(t) * 128; \
        __builtin_amdgcn_global_load_lds((const unsigned*)(sA0 + _ko), (PG8_LAS unsigned*)(lds + _b + ldsw), 16, 0, 0); \
        __builtin_amdgcn_global_load_lds((const unsigned*)(sA1 + _ko), (PG8_LAS unsigned*)(lds + _b + 8192 + ldsw), 16, 0, 0); \
        __builtin_amdgcn_global_load_lds((const unsigned*)(sB + _ko), (PG8_LAS unsigned*)(lds + _b + 16384 + ldsw), 16, 0, 0); } while (0)
    f32x4 acc[4];
#pragma unroll
    for (int n = 0; n < 4; ++n) acc[n] = (f32x4){0.f, 0.f, 0.f, 0.f};
    asm volatile("s_waitcnt vmcnt(0)" ::: "memory");
    SM_STAGE(0); SM_STAGE(1); SM_STAGE(2);
    for (int t = 0; t < nkt; ++t) {
        const int rem = nkt - 1 - t;
        if (rem >= 2) asm volatile("s_waitcnt vmcnt(6)" ::: "memory"); else if (rem == 1) asm volatile("s_waitcnt vmcnt(3)" ::: "memory"); else asm volatile("s_waitcnt vmcnt(0)" ::: "memory");
        asm volatile("s_waitcnt lgkmcnt(0)" ::: "memory");
        __builtin_amdgcn_s_barrier();
        asm volatile("" ::: "memory");
        if (t + 3 < nkt) SM_STAGE(t + 3);
        const int b = (t & 3) * SLOT;
        bf16x8 af[2], bf[4][2];
#pragma unroll
        for (int k = 0; k < 2; ++k) af[k] = *(const PG8_LAS bf16x8*)(lds + b + foff + wid * 2048 + k * 1024);
#pragma unroll
        for (int n = 0; n < 4; ++n)
#pragma unroll
            for (int k = 0; k < 2; ++k) bf[n][k] = *(const PG8_LAS bf16x8*)(lds + b + 16384 + foff + n * 2048 + k * 1024);
#pragma unroll
        for (int n = 0; n < 4; ++n)
#pragma unroll
            for (int k = 0; k < 2; ++k) acc[n] = __builtin_amdgcn_mfma_f32_16x16x32_bf16(bf[n][k], af[k], acc[n], 0, 0, 0);
    }
    E(acc, wid * 16 + fr, fq);
    asm volatile("s_waitcnt lgkmcnt(0)" ::: "memory");
    __builtin_amdgcn_s_barrier();
    asm volatile("" ::: "memory");
#undef SM_STAGE
}
struct BRowLin { int r0; __device__ __forceinline__ int operator()(int R) const { return r0 + R; } };
struct BRowGU { int j, q; __device__ __forceinline__ int operator()(int R) const { return 256 * j + 32 * q + (R & 31) + ((R >> 5) << 7); } };
struct SEpiIn {
    bf16_t* P; float* ZF; int c0;
    __device__ __forceinline__ void operator()(const f32x4 (&acc)[4], int row, int fq) const {
        const int typ = c0 >> 10;
#pragma unroll
        for (int n = 0; n < 4; ++n) { const int c = c0 + 16 * n + 4 * fq; f32x4 v = acc[n];
            if (typ == 3) { *(f32x4*)(ZF + (size_t)row * 1024 + (c - 3072)) = v; continue; }
            if (typ <= 1) { const f32x2 a = gelu_pk((f32x2){v[0], v[1]}), b = gelu_pk((f32x2){v[2], v[3]}); v = (f32x4){a.x, a.y, b.x, b.y}; }
            else if (typ != 4) v = (f32x4){silu_f(v[0]), silu_f(v[1]), silu_f(v[2]), silu_f(v[3])};
            typedef unsigned u32x2 __attribute__((ext_vector_type(2))); u32x2 w; w.x = cvt_pk_bf16(v[0], v[1]); w.y = cvt_pk_bf16(v[2], v[3]);
            *(u32x2*)(P + (size_t)row * 6144 + c) = w; }
    }
};
struct SEpiF32 { float* O; int ldc; int c0;
    __device__ __forceinline__ void operator()(const f32x4 (&acc)[4], int row, int fq) const {
#pragma unroll
        for (int n = 0; n < 4; ++n) *(f32x4*)(O + (size_t)row * ldc + c0 + 16 * n + 4 * fq) = acc[n]; }
};
struct SEpiF32WT { float* O; int ldc; int c0;
    __device__ __forceinline__ void operator()(const f32x4 (&acc)[4], int row, int fq) const {
        const __amdgpu_buffer_rsrc_t r = __builtin_amdgcn_make_buffer_rsrc((void*)O, (short)0, 0x7fffffff, 0x00020000);
#pragma unroll
        for (int n = 0; n < 4; ++n) __builtin_amdgcn_raw_buffer_store_b128(__builtin_bit_cast(u32x4, acc[n]), r, (unsigned)(((size_t)row * ldc + c0 + 16 * n + 4 * fq) * 4), 0, 16); }
};
struct SEpiGU { bf16_t* O; int ldc; int c0;
    __device__ __forceinline__ void operator()(const f32x4 (&acc)[4], int row, int fq) const {
#pragma unroll
        for (int n = 0; n < 2; ++n) { const f32x4 g = acc[n], u = acc[n + 2];
            typedef unsigned u32x2 __attribute__((ext_vector_type(2))); u32x2 w; w.x = cvt_pk_bf16(silu_f(g[0]) * u[0], silu_f(g[1]) * u[1]); w.y = cvt_pk_bf16(silu_f(g[2]) * u[2], silu_f(g[3]) * u[3]);
            *(u32x2*)(O + (size_t)row * ldc + c0 + 16 * n + 4 * fq) = w; }
    }
};
}
constexpr int NWAVES = 8;
#ifndef MK_MULTI
#define MK_MULTI 0
#endif
#ifndef DUP_CONV
#define DUP_CONV 0
#endif
#ifndef DUP_NORM
#define DUP_NORM 0
#endif
#ifndef DUP_MIX
#define DUP_MIX 0
#endif
#ifndef DUP_GEMM
#define DUP_GEMM 0
#endif
constexpr int DM = 2048, MP = 8192, MS = 128, MREAL = MP + MS, MT = 8448;
constexpr int INW = 6144, DFF = 5632, AW = 1024, DEPTH = 4, SEQ = 2048, NB = 4;
constexpr float EPS = 1e-6f;
constexpr size_t MiB = 1u << 20;
constexpr size_t WS_CTL = 0, CTL_ZERO_BYTES = 1 * MiB;
constexpr size_t WS_LB = 1 * MiB;
constexpr size_t WS_WIN = 2 * MiB, WS_WOUT = 98 * MiB, WS_WGU = 130 * MiB, WS_WDN = 306 * MiB;
constexpr size_t WS_X = 394 * MiB, WS_H = 460 * MiB, WS_PROJ = 493 * MiB, WS_ZF = 592 * MiB, WS_MIXIN = 625 * MiB, WS_MIX = 658 * MiB, WS_ACT = 724 * MiB, WS_MIXS = 816 * MiB, WS_HQF = 820 * MiB, WS_HKET = 836 * MiB, WS_HIT = 852 * MiB, WS_HOI = 868 * MiB, WS_HDL = 884 * MiB, WS_END = 888 * MiB;
static_assert(WS_WIN + (size_t)DEPTH * INW * DM * 2 <= WS_WOUT && WS_WOUT + (size_t)DEPTH * DM * DM * 2 <= WS_WGU && WS_WGU + (size_t)DEPTH * 2 * DFF * DM * 2 <= WS_WDN && WS_WDN + (size_t)DEPTH * DM * DFF * 2 <= WS_X, "ws map (weights)");
static_assert(WS_X + (size_t)MT * DM * 4 <= WS_H && WS_H + (size_t)MT * DM * 2 <= WS_PROJ && WS_PROJ + (size_t)MT * INW * 2 <= WS_ZF && WS_ZF + (size_t)MT * AW * 4 <= WS_MIXIN && WS_MIXIN + (size_t)MT * DM * 2 <= WS_MIX && WS_MIX + (size_t)MT * DM * 4 <= WS_ACT && WS_ACT + (size_t)MT * DFF * 2 <= WS_MIXS, "ws map (activations)");
#ifndef FUSE_NORM
#define FUSE_NORM 1
#endif
constexpr int CW_BAR = 4096, CW_CNT0 = 32768, CW_FLAG0 = 131072;
constexpr size_t OUT_Y = 0, OUT_SP = 17039360, OUT_SS = 19136512, OUT_VP = 86245376, OUT_VS = 88342528, OUT_TOTAL = 88866816;
constexpr int RING_BYTES = 131072, LDSCTL_OFF = RING_BYTES, MISC_OFF = LDSCTL_OFF + 320, XTRA_OFF = LDSCTL_OFF + 1024, LDS_BYTES = 147456;

typedef unsigned short bf16;
typedef unsigned v4u __attribute__((ext_vector_type(4)));
typedef unsigned v2u __attribute__((ext_vector_type(2)));
typedef float f32x4 __attribute__((ext_vector_type(4)));
#define GAS __attribute__((address_space(1)))
#define LAS __attribute__((address_space(3)))
typedef GAS unsigned gu32;
#define RLX_AGENT __ATOMIC_RELAXED, __HIP_MEMORY_SCOPE_AGENT
#define LDS_WAIT() asm volatile("s_waitcnt lgkmcnt(0)" ::: "memory")
typedef float f32x2_t __attribute__((ext_vector_type(2))); typedef __bf16 bf16x2_t __attribute__((ext_vector_type(2)));
__device__ __forceinline__ unsigned pk2(float lo, float hi) { f32x2_t v = {lo, hi}; bf16x2_t b = __builtin_convertvector(v, bf16x2_t); return __builtin_bit_cast(unsigned, b); }
__device__ __forceinline__ float bf2f(unsigned short b) { return __uint_as_float((unsigned)b << 16); }
__device__ __forceinline__ float bflo(unsigned w) { return __uint_as_float(w << 16); }
__device__ __forceinline__ float bfhi(unsigned w) { return __uint_as_float(w & 0xffff0000u); }
__device__ __forceinline__ float wave_sum(float v) {
#pragma unroll
    for (int o = 1; o < 64; o <<= 1) v += __shfl_xor(v, o);
    return v;
}
__device__ __forceinline__ float sigmoid_f(float x) { return 1.0f / (1.0f + __expf(-x)); }
#define XB_TMO      128
#define XB_XCNT(j)  (256  + 64 * (j))
#define XB_XSUB(j)  (1280 + 64 * (j))
#define XB_XGEN(j)  (2304 + 64 * (j))
#define XB_TOP      3328
#define XB_TOPGEN   3392
#define XCD_BAR_WORDS 3456
#define XB_SPIN_CAP (1u << 18)

__device__ __forceinline__ unsigned xb_ld(unsigned* p)              { return __hip_atomic_load(p, __ATOMIC_RELAXED, __HIP_MEMORY_SCOPE_AGENT); }
__device__ __forceinline__ unsigned xb_add(unsigned* p, unsigned v) { return __hip_atomic_fetch_add(p, v, __ATOMIC_RELAXED, __HIP_MEMORY_SCOPE_AGENT); }
__device__ __forceinline__ unsigned xb_xcc_id() { return (unsigned)__builtin_amdgcn_s_getreg((3 << 11) | 20) & 0xFu; }
#define XB_SPIN(cond, bar) do { unsigned _sp = 0; while (cond) { __builtin_amdgcn_s_sleep(1); \
    if ((++_sp & 255u) == 0u) { if (xb_ld(&(bar)[XB_TMO])) break; if (_sp > XB_SPIN_CAP) { atomicAdd(&(bar)[XB_TMO], 1u); break; } } } } while (0)

struct XcdBarrier {
    unsigned* bar; unsigned x;
    volatile LAS unsigned* st;
};

__device__ __forceinline__ XcdBarrier xcd_barrier_post(unsigned* bar, volatile LAS unsigned* st) {
    XcdBarrier b; b.bar = bar; b.x = xb_xcc_id(); b.st = st;
    if (threadIdx.x == 0) (void)xb_add(&bar[XB_XCNT(b.x)], 1u);
    return b;
}
__device__ __forceinline__ void xcd_barrier_complete(unsigned* bar, unsigned x, unsigned& nloc, unsigned& nx) {
    const unsigned G = gridDim.x * gridDim.y * gridDim.z;
    unsigned sum, cnt, mine, sp = 0u;
    for (;;) {
        sum = 0u; cnt = 0u; mine = 0u;
#pragma unroll
        for (unsigned j = 0; j < 16; ++j) { const unsigned c = xb_ld(&bar[XB_XCNT(j)]); sum += c; cnt += (c > 0u) ? 1u : 0u; mine = (j == x) ? c : mine; }
        if (sum == G) break;
        __builtin_amdgcn_s_sleep(1);
        if ((++sp & 255u) == 0u) { if (xb_ld(&bar[XB_TMO])) break; if (sp > XB_SPIN_CAP) { atomicAdd(&bar[XB_TMO], 1u); break; } }
    }
    nloc = mine > 0u ? mine : 1u; nx = cnt > 0u ? cnt : 1u;
}

__device__ __forceinline__ void xcd_barrier(const XcdBarrier& b) {
    asm volatile("s_waitcnt vmcnt(0)" ::: "memory");
    __syncthreads();
    if (threadIdx.x == 0) {
        unsigned* bar = b.bar;
        __builtin_amdgcn_s_waitcnt(0);
        unsigned nloc = b.st[0], nx = b.st[1];
        if (nloc == 0u) { xcd_barrier_complete(bar, b.x, nloc, nx); b.st[0] = nloc; b.st[1] = nx; }
        const unsigned old = xb_add(&bar[XB_XSUB(b.x)], 1u);
        const unsigned gen = old / nloc;
        if (old + 1u == (gen + 1u) * nloc) {
            __builtin_amdgcn_fence(__ATOMIC_RELEASE, "agent");
            asm volatile("s_waitcnt vmcnt(0)" ::: "memory");
            const unsigned og = xb_add(&bar[XB_TOP], 1u);
            const unsigned tg = og / nx;
            if (og + 1u == (tg + 1u) * nx) xb_add(&bar[XB_TOPGEN], 1u);
            else XB_SPIN(xb_ld(&bar[XB_TOPGEN]) == tg, bar);
            __builtin_amdgcn_fence(__ATOMIC_ACQUIRE, "agent");
            xb_add(&bar[XB_XGEN(b.x)], 1u);
            asm volatile("s_waitcnt vmcnt(0)" ::: "memory");
        } else {
            XB_SPIN(xb_ld(&bar[XB_XGEN(b.x)]) == gen, bar);
            __builtin_amdgcn_fence(__ATOMIC_ACQUIRE, "agent");
            asm volatile("s_waitcnt vmcnt(0)" ::: "memory");
        }
    }
    __syncthreads();
}
__device__ __forceinline__ void p0_transpose_item(const float* W, int K, int N, bf16* WT, int mode, LAS float* scr, int item, int lane) {
    const int nblk = N / 32, kb = item / nblk, nb = item % nblk, k0 = 64 * kb, n0 = 32 * nb;
    const int r0 = (mode == 0) ? n0 : (256 * (n0 >> 7) + (n0 & 127) + (mode == 2 ? 128 : 0));
    f32x4 x[8];
#pragma unroll
    for (int i = 0; i < 8; ++i) x[i] = __builtin_nontemporal_load((const f32x4*)(W + (size_t)(k0 + (lane >> 3) + 8 * i) * N + n0 + 4 * (lane & 7)));
#pragma unroll
    for (int i = 0; i < 8; ++i) { LAS float* d = scr + ((lane >> 3) + 8 * i) * 33 + 4 * (lane & 7); d[0] = x[i].x; d[1] = x[i].y; d[2] = x[i].z; d[3] = x[i].w; }
    LDS_WAIT(); asm volatile("" ::: "memory");
    const int c = lane & 7;
#pragma unroll
    for (int j = 0; j < 4; ++j) { const int n = (lane >> 3) + 8 * j; const LAS float* s = scr + (8 * c) * 33 + n;
        v4u o; o.x = pk2(s[0 * 33], s[1 * 33]); o.y = pk2(s[2 * 33], s[3 * 33]); o.z = pk2(s[4 * 33], s[5 * 33]); o.w = pk2(s[6 * 33], s[7 * 33]);
        *(GAS v4u*)(WT + (size_t)(r0 + n) * K + k0 + 8 * c) = o; }
    LDS_WAIT(); asm volatile("" ::: "memory");
}
struct WPtrs { const float* w_in; const float* w_out; const float* w_gate; const float* w_up; const float* w_down; bf16* Win_t; bf16* Wout_t; bf16* Wgu_t; bf16* Wdn_t; };
__device__ __forceinline__ void convert_layer(const WPtrs& P, int l, int wv, int NW, LAS float* scr, int lane, int part = 0) {
    constexpr int I_IN = (DM / 64) * (INW / 32), I_OUT = (DM / 64) * (DM / 32), I_G = (DM / 64) * (DFF / 32), I_D = (DFF / 64) * (DM / 32), I_L = I_IN + I_OUT + 2 * I_G + I_D;
    const int lo = (part == 10) ? I_IN : (part == 8) ? I_IN + I_OUT : (part == 9) ? I_IN + I_OUT + I_G : (part == 6) ? I_L - I_D : 0;
    const int hi = (part == 11) ? I_IN : (part == 1 || part == 10) ? I_IN + I_OUT : (part == 8) ? I_IN + I_OUT + I_G : (part == 9) ? I_IN + I_OUT + 2 * I_G : I_L;
    for (int it = lo + wv; it < hi; it += NW) {
        int r = it;
        if (r < I_IN) { p0_transpose_item(P.w_in + (size_t)l * DM * INW, DM, INW, P.Win_t + (size_t)l * INW * DM, 0, scr, r, lane); continue; } r -= I_IN;
        if (r < I_OUT) { p0_transpose_item(P.w_out + (size_t)l * DM * DM, DM, DM, P.Wout_t + (size_t)l * DM * DM, 0, scr, r, lane); continue; } r -= I_OUT;
        if (r < I_G) { p0_transpose_item(P.w_gate + (size_t)l * DM * DFF, DM, DFF, P.Wgu_t + (size_t)l * 2 * DFF * DM, 1, scr, r, lane); continue; } r -= I_G;
        if (r < I_G) { p0_transpose_item(P.w_up + (size_t)l * DM * DFF, DM, DFF, P.Wgu_t + (size_t)l * 2 * DFF * DM, 2, scr, r, lane); continue; } r -= I_G;
        p0_transpose_item(P.w_down + (size_t)l * DFF * DM, DFF, DM, P.Wdn_t + (size_t)l * DM * DFF, 0, scr, r, lane);
    }
}
__device__ __forceinline__ void norm_in_row(const float* xrow, const float* g, bf16* hrow, int lane) {
    f32x4 v[8]; float ss = 0.f;
#pragma unroll
    for (int j = 0; j < 8; ++j) { v[j] = ((const f32x4*)xrow)[lane + 64 * j]; ss += (v[j].x * v[j].x + v[j].y * v[j].y) + (v[j].z * v[j].z + v[j].w * v[j].w); }
    const float rstd = 1.0f / sqrtf(wave_sum(ss) * (1.0f / DM) + EPS);
#pragma unroll
    for (int j = 0; j < 8; ++j) { const f32x4 gv = ((const f32x4*)g)[lane + 64 * j]; v2u o; o.x = pk2(v[j].x * rstd * gv.x, v[j].y * rstd * gv.y); o.y = pk2(v[j].z * rstd * gv.z, v[j].w * rstd * gv.w);
        ((v2u*)hrow)[lane + 64 * j] = o; }
}
template <bool BF> __device__ __forceinline__ void ld8(const void* row, int lane, int j, float (&o)[8]) {
    if (BF) { const v4u a = ((const v4u*)row)[lane + 64 * j]; o[0] = bflo(a.x); o[1] = bfhi(a.x); o[2] = bflo(a.y); o[3] = bfhi(a.y); o[4] = bflo(a.z); o[5] = bfhi(a.z); o[6] = bflo(a.w); o[7] = bfhi(a.w); }
    else { const f32x4 a = ((const f32x4*)row)[2 * (lane + 64 * j)], c = ((const f32x4*)row)[2 * (lane + 64 * j) + 1]; o[0] = a.x; o[1] = a.y; o[2] = a.z; o[3] = a.w; o[4] = c.x; o[5] = c.y; o[6] = c.z; o[7] = c.w; }
}
__device__ __forceinline__ void ld8_sc1(__amdgpu_buffer_rsrc_t r, size_t row_byte_off, int lane, int j, float (&o)[8]) {
    const v4u a = __builtin_amdgcn_raw_buffer_load_b128(r, (unsigned)(row_byte_off + (size_t)(lane + 64 * j) * 16), 0, 16);
    o[0] = bflo(a.x); o[1] = bfhi(a.x); o[2] = bflo(a.y); o[3] = bfhi(a.y); o[4] = bflo(a.z); o[5] = bfhi(a.z); o[6] = bflo(a.w); o[7] = bfhi(a.w);
}
template <bool XBF> __device__ __forceinline__ void norm_res_row2_sc1(__amdgpu_buffer_rsrc_t rmix, size_t m, const void* x0, size_t xstride_bytes, const float* gpost, bf16* xb0, float* y0, const float* gpre, bf16* h0, int lane) {
    float v[2][4][8]; float ss[2] = {0.f, 0.f};
#pragma unroll
    for (int r = 0; r < 2; ++r)
#pragma unroll
        for (int j = 0; j < 4; ++j) { ld8_sc1(rmix, (m + r) * (size_t)DM * 2, lane, j, v[r][j]);
#pragma unroll
            for (int e = 0; e < 8; ++e) ss[r] += v[r][j][e] * v[r][j][e]; }
    float x[2][4][8];
#pragma unroll
    for (int r = 0; r < 2; ++r)
#pragma unroll
        for (int j = 0; j < 4; ++j) ld8<XBF>((const char*)x0 + r * xstride_bytes, lane, j, x[r][j]);
    const float rs0 = __builtin_amdgcn_rsqf(wave_sum(ss[0]) * (1.0f / DM) + EPS), rs1 = __builtin_amdgcn_rsqf(wave_sum(ss[1]) * (1.0f / DM) + EPS);
    float ss1[2] = {0.f, 0.f};
#pragma unroll
    for (int j = 0; j < 4; ++j) { float g[8]; ld8<false>(gpost, lane, j, g);
#pragma unroll
        for (int r = 0; r < 2; ++r) { const float rs = r ? rs1 : rs0;
#pragma unroll
            for (int e = 0; e < 8; ++e) { v[r][j][e] = x[r][j][e] + v[r][j][e] * rs * g[e]; ss1[r] += v[r][j][e] * v[r][j][e]; }
            if (xb0) ((v4u*)(xb0 + (size_t)r * DM))[lane + 64 * j] = (v4u){pk2(v[r][j][0], v[r][j][1]), pk2(v[r][j][2], v[r][j][3]), pk2(v[r][j][4], v[r][j][5]), pk2(v[r][j][6], v[r][j][7])};
            if (y0) { f32x4* yp = (f32x4*)(y0 + (size_t)r * DM); yp[2 * (lane + 64 * j)] = (f32x4){v[r][j][0], v[r][j][1], v[r][j][2], v[r][j][3]}; yp[2 * (lane + 64 * j) + 1] = (f32x4){v[r][j][4], v[r][j][5], v[r][j][6], v[r][j][7]}; } } }
    if (h0) {
        const float q0 = __builtin_amdgcn_rsqf(wave_sum(ss1[0]) * (1.0f / DM) + EPS), q1 = __builtin_amdgcn_rsqf(wave_sum(ss1[1]) * (1.0f / DM) + EPS);
#pragma unroll
        for (int j = 0; j < 4; ++j) { float g[8]; ld8<false>(gpre, lane, j, g);
#pragma unroll
            for (int r = 0; r < 2; ++r) { const float q = r ? q1 : q0;
                ((v4u*)(h0 + (size_t)r * DM))[lane + 64 * j] = (v4u){pk2(v[r][j][0] * q * g[0], v[r][j][1] * q * g[1]), pk2(v[r][j][2] * q * g[2], v[r][j][3] * q * g[3]), pk2(v[r][j][4] * q * g[4], v[r][j][5] * q * g[5]), pk2(v[r][j][6] * q * g[6], v[r][j][7] * q * g[7])}; } }
    }
}
template <bool XBF> __device__ __forceinline__ void norm_res_row_s(__amdgpu_buffer_rsrc_t rm, size_t row_off, int nslab, size_t slab_bytes, const void* xrow, const float* gpost, bf16* xb, float* yout, const float* gpre, bf16* hrow, int lane) {
    float v[4][8]; float ss = 0.f;
#pragma unroll
    for (int j = 0; j < 4; ++j) {
#pragma unroll
        for (int e = 0; e < 8; ++e) v[j][e] = 0.f;
        _Pragma("unroll 1") for (int sl = 0; sl < nslab; ++sl) { const unsigned o = (unsigned)(row_off + sl * slab_bytes + (size_t)(lane + 64 * j) * 32);
            const v4u a = __builtin_amdgcn_raw_buffer_load_b128(rm, o, 0, 16), c = __builtin_amdgcn_raw_buffer_load_b128(rm, o + 16, 0, 16);
            v[j][0] += __uint_as_float(a.x); v[j][1] += __uint_as_float(a.y); v[j][2] += __uint_as_float(a.z); v[j][3] += __uint_as_float(a.w);
            v[j][4] += __uint_as_float(c.x); v[j][5] += __uint_as_float(c.y); v[j][6] += __uint_as_float(c.z); v[j][7] += __uint_as_float(c.w); }
#pragma unroll
        for (int e = 0; e < 8; ++e) ss += v[j][e] * v[j][e]; }
    const float rstd = __builtin_amdgcn_rsqf(wave_sum(ss) * (1.0f / DM) + EPS);
    float ss1 = 0.f;
#pragma unroll
    for (int j = 0; j < 4; ++j) { float g[8], x[8]; ld8<false>(gpost, lane, j, g); ld8<XBF>(xrow, lane, j, x);
#pragma unroll
        for (int e = 0; e < 8; ++e) { v[j][e] = x[e] + v[j][e] * rstd * g[e]; ss1 += v[j][e] * v[j][e]; }
        if (xb) ((v4u*)xb)[lane + 64 * j] = (v4u){pk2(v[j][0], v[j][1]), pk2(v[j][2], v[j][3]), pk2(v[j][4], v[j][5]), pk2(v[j][6], v[j][7])};
        if (yout) { ((f32x4*)yout)[2 * (lane + 64 * j)] = (f32x4){v[j][0], v[j][1], v[j][2], v[j][3]}; ((f32x4*)yout)[2 * (lane + 64 * j) + 1] = (f32x4){v[j][4], v[j][5], v[j][6], v[j][7]}; } }
    if (hrow) {
        const float rstd1 = __builtin_amdgcn_rsqf(wave_sum(ss1) * (1.0f / DM) + EPS);
#pragma unroll
        for (int j = 0; j < 4; ++j) { float g[8]; ld8<false>(gpre, lane, j, g);
            ((v4u*)hrow)[lane + 64 * j] = (v4u){pk2(v[j][0] * rstd1 * g[0], v[j][1] * rstd1 * g[1]), pk2(v[j][2] * rstd1 * g[2], v[j][3] * rstd1 * g[3]), pk2(v[j][4] * rstd1 * g[4], v[j][5] * rstd1 * g[5]), pk2(v[j][6] * rstd1 * g[6], v[j][7] * rstd1 * g[7])}; }
    }
}
__device__ __forceinline__ void sample_count(unsigned* cnt, int n, int tid) {
    asm volatile("s_waitcnt vmcnt(0)" ::: "memory"); __syncthreads();
    if (tid == 0 && n > 0) __hip_atomic_fetch_add(cnt, (unsigned)n, __ATOMIC_RELAXED, __HIP_MEMORY_SCOPE_AGENT);
}
__device__ __forceinline__ void sample_wait(unsigned* cnt, unsigned want, int tid) {
    if (tid == 0) { unsigned sp = 0u; while (__hip_atomic_load(cnt, __ATOMIC_RELAXED, __HIP_MEMORY_SCOPE_AGENT) < want) { __builtin_amdgcn_s_sleep(2); if (++sp > (1u << 17)) break; } }
    __syncthreads(); asm volatile("" ::: "memory");
}
__device__ __forceinline__ bool panel_wait(unsigned* cnt, int tid) {
    __syncthreads();
    if (tid == 0) { __hip_atomic_fetch_add(cnt, 1u, __ATOMIC_RELAXED, __HIP_MEMORY_SCOPE_AGENT);
        unsigned sp = 0u; while (__hip_atomic_load(cnt, __ATOMIC_RELAXED, __HIP_MEMORY_SCOPE_AGENT) < 8u) { __builtin_amdgcn_s_sleep(2); if (++sp > (1u << 17)) break; } }
    __syncthreads();
    asm volatile("" ::: "memory");
    return true;
}
template <bool MIXBF, bool XBF> __device__ __forceinline__ void norm_res_row(const void* mixrow, int nslab, size_t slab_stride, const void* xrow, const float* gpost, bf16* xb, float* yout, const float* gpre, bf16* hrow, int lane) {
    float v[4][8]; float ss = 0.f;
#pragma unroll
    for (int j = 0; j < 4; ++j) { ld8<MIXBF>(mixrow, lane, j, v[j]);
        if (!MIXBF) for (int sl = 1; sl < nslab; ++sl) { float p[8]; ld8<false>((const float*)mixrow + sl * slab_stride, lane, j, p);
#pragma unroll
            for (int e = 0; e < 8; ++e) v[j][e] += p[e]; }
#pragma unroll
        for (int e = 0; e < 8; ++e) ss += v[j][e] * v[j][e]; }
    const float rstd = __builtin_amdgcn_rsqf(wave_sum(ss) * (1.0f / DM) + EPS);
    float ss1 = 0.f;
#pragma unroll
    for (int j = 0; j < 4; ++j) { float g[8], x[8]; ld8<false>(gpost, lane, j, g); ld8<XBF>(xrow, lane, j, x);
#pragma unroll
        for (int e = 0; e < 8; ++e) { v[j][e] = x[e] + v[j][e] * rstd * g[e]; ss1 += v[j][e] * v[j][e]; }
        if (xb) ((v4u*)xb)[lane + 64 * j] = (v4u){pk2(v[j][0], v[j][1]), pk2(v[j][2], v[j][3]), pk2(v[j][4], v[j][5]), pk2(v[j][6], v[j][7])};
        if (yout) { ((f32x4*)yout)[2 * (lane + 64 * j)] = (f32x4){v[j][0], v[j][1], v[j][2], v[j][3]}; ((f32x4*)yout)[2 * (lane + 64 * j) + 1] = (f32x4){v[j][4], v[j][5], v[j][6], v[j][7]}; } }
    if (hrow) {
        const float rstd1 = __builtin_amdgcn_rsqf(wave_sum(ss1) * (1.0f / DM) + EPS);
#pragma unroll
        for (int j = 0; j < 4; ++j) { float g[8]; ld8<false>(gpre, lane, j, g);
            ((v4u*)hrow)[lane + 64 * j] = (v4u){pk2(v[j][0] * rstd1 * g[0], v[j][1] * rstd1 * g[1]), pk2(v[j][2] * rstd1 * g[2], v[j][3] * rstd1 * g[3]), pk2(v[j][4] * rstd1 * g[4], v[j][5] * rstd1 * g[5]), pk2(v[j][6] * rstd1 * g[6], v[j][7] * rstd1 * g[7])}; }
    }
}

struct MixArgs {
    int l;
    bf16* PROJ; float* ZF; bf16* MIXIN; const float* LB;
    const float* ln_g; const float* ln_b; const float* sw; const float* sb; const float* gout;
    const float* state_in;
    float* out;
};
__device__ __forceinline__ void hgrn_prompt_item(const MixArgs& A, int b, int h, LAS unsigned char* lds, int tid) {
    LAS float* F = (LAS float*)lds; LAS float* KK = F + 2048; LAS float* Q = KK + 2048; LAS float* I = Q + 2048; LAS float* OP = I + 2048;
    const int v = tid & 127, kg = tid >> 7;
    float S[32];
#pragma unroll
    for (int j = 0; j < 32; ++j) S[j] = 0.f;
    const float lbv = A.LB[A.l * 1024 + h * 128 + (tid & 127)];
    for (int t0 = 0; t0 < SEQ; t0 += 16) {
        const int m0 = b * SEQ + t0;
#pragma unroll
        for (int i = 0; i < 4; ++i) { const int t = (tid >> 7) + 4 * i, k = tid & 127; const size_t row = (size_t)(m0 + t);
            const float z = A.ZF[row * 1024 + h * 128 + k]; const float sg = sigmoid_f(z);
            F[t * 128 + k] = lbv + (1.0f - lbv) * sg; KK[t * 128 + k] = (1.0f - lbv) * (1.0f - sg);
            Q[t * 128 + k] = bf2f(A.PROJ[row * INW + 2048 + h * 128 + k]); I[t * 128 + k] = bf2f(A.PROJ[row * INW + 4096 + h * 128 + k]); }
        __syncthreads();
#pragma unroll 1
        for (int t = 0; t < 16; ++t) {
            const float iv = I[t * 128 + v]; float op = 0.f;
#pragma unroll
            for (int jj = 0; jj < 8; ++jj) {
                const f32x4 f4 = *(LAS f32x4*)(F + t * 128 + 32 * kg + 4 * jj), k4 = *(LAS f32x4*)(KK + t * 128 + 32 * kg + 4 * jj), q4 = *(LAS f32x4*)(Q + t * 128 + 32 * kg + 4 * jj);
                S[4 * jj + 0] = f4.x * S[4 * jj + 0] + k4.x * iv; op += S[4 * jj + 0] * q4.x;
                S[4 * jj + 1] = f4.y * S[4 * jj + 1] + k4.y * iv; op += S[4 * jj + 1] * q4.y;
                S[4 * jj + 2] = f4.z * S[4 * jj + 2] + k4.z * iv; op += S[4 * jj + 2] * q4.z;
                S[4 * jj + 3] = f4.w * S[4 * jj + 3] + k4.w * iv; op += S[4 * jj + 3] * q4.w;
            }
            OP[(t * 4 + kg) * 128 + v] = op;
        }
        __syncthreads();
        {   const int t = tid >> 5, vq = tid & 31; const size_t row = (size_t)(m0 + t);
            f32x4 o = *(LAS f32x4*)(OP + (t * 4 + 0) * 128 + 4 * vq);
#pragma unroll
            for (int g = 1; g < 4; ++g) { const f32x4 p = *(LAS f32x4*)(OP + (t * 4 + g) * 128 + 4 * vq); o.x += p.x; o.y += p.y; o.z += p.z; o.w += p.w; }
            float ss = (o.x * o.x + o.y * o.y) + (o.z * o.z + o.w * o.w);
#pragma unroll
            for (int d = 1; d < 32; d <<= 1) ss += __shfl_xor(ss, d);
            const float rstd = 1.0f / sqrtf(ss * (1.0f / 128.0f) + EPS);
            const f32x4 go = *(const f32x4*)(A.gout + h * 128 + 4 * vq);
            const v2u sg = *(const v2u*)(A.PROJ + row * INW + 5120 + h * 128 + 4 * vq);
            v2u w; w.x = pk2(o.x * rstd * go.x * bflo(sg.x), o.y * rstd * go.y * bfhi(sg.x)); w.y = pk2(o.z * rstd * go.z * bflo(sg.y), o.w * rstd * go.w * bfhi(sg.y));
            *(v2u*)(A.MIXIN + row * DM + 1024 + h * 128 + 4 * vq) = w; }
    }
    float* sp = A.out + OUT_SP + ((size_t)((A.l * NB + b) * 8 + h) * 128) * 128;
#pragma unroll
    for (int j = 0; j < 32; ++j) sp[(size_t)(32 * kg + j) * 128 + v] = S[j];
    __syncthreads();
}
__device__ __forceinline__ void hgrn_sample_item(const MixArgs& A, int b, int h, LAS unsigned char* lds, int tid) {
    LAS float* OPART = (LAS float*)lds;
    const int lane = tid & 63, w = tid >> 6, vq = lane & 31, par = lane >> 5;
    const size_t row = (size_t)(MP + b);
    const float* s0 = A.state_in + ((size_t)(b * 8 + h) * 128) * 128;
    float* s1 = A.out + OUT_SS + ((size_t)((A.l * MS + b) * 8 + h) * 128) * 128;
    const v2u ib = *(const v2u*)(A.PROJ + row * INW + 4096 + h * 128 + 4 * vq);
    const f32x4 i4 = (f32x4){bflo(ib.x), bfhi(ib.x), bflo(ib.y), bfhi(ib.y)};
    f32x4 o = (f32x4){0.f, 0.f, 0.f, 0.f};
    f32x4 sv[8];
#pragma unroll
    for (int it = 0; it < 8; ++it) { const int k = 16 * w + 2 * it + par; sv[it] = *(const f32x4*)(s0 + (size_t)k * 128 + 4 * vq); }
#pragma unroll
    for (int it = 0; it < 8; ++it) { const int k = 16 * w + 2 * it + par;
        const float z = A.ZF[row * 1024 + h * 128 + k]; const float lbv = A.LB[A.l * 1024 + h * 128 + k]; const float sg = sigmoid_f(z);
        const float f = lbv + (1.0f - lbv) * sg, kk = (1.0f - lbv) * (1.0f - sg); const float q = bf2f(A.PROJ[row * INW + 2048 + h * 128 + k]);
        f32x4 sn; sn.x = f * sv[it].x + kk * i4.x; sn.y = f * sv[it].y + kk * i4.y; sn.z = f * sv[it].z + kk * i4.z; sn.w = f * sv[it].w + kk * i4.w;
        *(f32x4*)(s1 + (size_t)k * 128 + 4 * vq) = sn;
        o.x += sn.x * q; o.y += sn.y * q; o.z += sn.z * q; o.w += sn.w * q; }
    o.x += __shfl_xor(o.x, 32); o.y += __shfl_xor(o.y, 32); o.z += __shfl_xor(o.z, 32); o.w += __shfl_xor(o.w, 32);
    if (par == 0) *(LAS f32x4*)(OPART + w * 128 + 4 * vq) = o;
    __syncthreads();
    if (w == 0) {
        float o0 = 0.f, o1 = 0.f;
#pragma unroll
        for (int g = 0; g < 8; ++g) { o0 += OPART[g * 128 + 2 * lane]; o1 += OPART[g * 128 + 2 * lane + 1]; }
        const float rstd = 1.0f / sqrtf(wave_sum(o0 * o0 + o1 * o1) * (1.0f / 128.0f) + EPS);
        const unsigned sg = *(const unsigned*)(A.PROJ + row * INW + 5120 + h * 128 + 2 * lane);
        const float g0 = A.gout[h * 128 + 2 * lane], g1 = A.gout[h * 128 + 2 * lane + 1];
        *(unsigned*)(A.MIXIN + row * DM + 1024 + h * 128 + 2 * lane) = pk2(o0 * rstd * g0 * bflo(sg), o1 * rstd * g1 * bfhi(sg));
    }
    __syncthreads();
}
__device__ __forceinline__ void gmlp_prompt_item(const MixArgs& A, int b, int n, LAS unsigned char* lds, int tid) {
    LAS float* VL = (LAS float*)lds;
    LAS float* WT = VL + 16384;
    LAS float* MU = (LAS float*)(lds + XTRA_OFF);
    LAS float* RS = MU + 128;
    const int lane = tid & 63, w = tid >> 6;
    const int m0_ = b * SEQ + 128 * n;
    { const int m0 = m0_;
#pragma unroll 2
    for (int r = 0; r < 16; ++r) { const size_t row = (size_t)(m0 + 16 * w + r);
        const v4u a = *(const v4u*)(A.PROJ + row * INW + 1024 + 8 * lane), c = *(const v4u*)(A.PROJ + row * INW + 1024 + 512 + 8 * lane);
        float x[16] = {bflo(a.x), bfhi(a.x), bflo(a.y), bfhi(a.y), bflo(a.z), bfhi(a.z), bflo(a.w), bfhi(a.w), bflo(c.x), bfhi(c.x), bflo(c.y), bfhi(c.y), bflo(c.z), bfhi(c.z), bflo(c.w), bfhi(c.w)};
        float s = 0.f;
#pragma unroll
        for (int i = 0; i < 16; ++i) s += x[i];
        const float mu = wave_sum(s) * (1.0f / 1024.0f); float q = 0.f;
#pragma unroll
        for (int i = 0; i < 16; ++i) { const float d = x[i] - mu; q += d * d; }
        const float rs = 1.0f / sqrtf(wave_sum(q) * (1.0f / 1024.0f) + EPS);
        if (lane == 0) { MU[16 * w + r] = mu; RS[16 * w + r] = rs; } }
    }
    __syncthreads();
    const int d = tid & 127, tg = tid >> 7;
    for (int h = 0; h < 8; ++h) {
        int m0 = __builtin_amdgcn_readfirstlane(m0_); asm volatile("" : "+s"(m0));
        const float lg = A.ln_g[h * 128 + d], lbias = A.ln_b[h * 128 + d];
#pragma unroll 4
        for (int i = 0; i < 32; ++i) { const int s = tg + 4 * i; const size_t row = (size_t)(m0 + s);
            const float vn = (bf2f(A.PROJ[row * INW + 1024 + h * 128 + d]) - MU[s]) * RS[s] * lg + lbias;
            VL[s * 128 + d] = vn;
            if (n == 15) A.out[OUT_VP + ((size_t)((A.l * NB + b) * 128 + s)) * 1024 + h * 128 + d] = vn; }
#pragma unroll 4
        for (int i = 0; i < 32; ++i) { const int t = tg + 4 * i; const int s = d;
            const float wv = A.sw[((size_t)h * 128 + t) * 128 + s]; WT[s * 128 + t] = (s <= t) ? wv : 0.f; }
        __syncthreads();
        float acc[32];
#pragma unroll
        for (int j = 0; j < 32; ++j) acc[j] = 0.f;
        const int smax = 32 * tg + 32;
#pragma unroll 2
        for (int s = 0; s < smax; ++s) { const float vv = VL[s * 128 + d];
#pragma unroll
            for (int jj = 0; jj < 8; ++jj) { const f32x4 w4 = *(LAS f32x4*)(WT + s * 128 + 32 * tg + 4 * jj);
                acc[4 * jj + 0] += w4.x * vv; acc[4 * jj + 1] += w4.y * vv; acc[4 * jj + 2] += w4.z * vv; acc[4 * jj + 3] += w4.w * vv; } }
#pragma unroll
        for (int j = 0; j < 32; ++j) { const int t = 32 * tg + j; const size_t row = (size_t)(m0 + t);
            const float u = bf2f(A.PROJ[row * INW + h * 128 + d]); const float o = u * (acc[j] + A.sb[h * 128 + t]);
            A.MIXIN[row * DM + h * 128 + d] = (bf16)(pk2(o, 0.f) & 0xffffu);
            if ((j & 3) == 3) asm volatile("" ::: "memory"); }
        __syncthreads();
    }
}
__device__ __forceinline__ void gmlp_sample_row(const MixArgs& A, int b, int lane) {
    const size_t row = (size_t)(MP + b);
    const v4u a = *(const v4u*)(A.PROJ + row * INW + 1024 + 8 * lane), c = *(const v4u*)(A.PROJ + row * INW + 1024 + 512 + 8 * lane);
    float x[16] = {bflo(a.x), bfhi(a.x), bflo(a.y), bfhi(a.y), bflo(a.z), bfhi(a.z), bflo(a.w), bfhi(a.w), bflo(c.x), bfhi(c.x), bflo(c.y), bfhi(c.y), bflo(c.z), bfhi(c.z), bflo(c.w), bfhi(c.w)};
    float s = 0.f;
#pragma unroll
    for (int i = 0; i < 16; ++i) s += x[i];
    const float mu = wave_sum(s) * (1.0f / 1024.0f); float q = 0.f;
#pragma unroll
    for (int i = 0; i < 16; ++i) { const float dd = x[i] - mu; q += dd * dd; }
    const float rs = 1.0f / sqrtf(wave_sum(q) * (1.0f / 1024.0f) + EPS);
    float* vs = A.out + OUT_VS + (size_t)(A.l * MS + b) * 1024;
#pragma unroll
    for (int half = 0; half < 2; ++half) { const int c0 = 512 * half + 8 * lane; const int h = c0 >> 7;
        const float w00 = A.sw[(size_t)h * 128 * 128], b0 = A.sb[h * 128];
        const v4u uu = *(const v4u*)(A.PROJ + row * INW + c0);
        const float uf[8] = {bflo(uu.x), bfhi(uu.x), bflo(uu.y), bfhi(uu.y), bflo(uu.z), bfhi(uu.z), bflo(uu.w), bfhi(uu.w)};
        float vn[8], o[8];
#pragma unroll
        for (int i = 0; i < 8; ++i) { vn[i] = (x[8 * half + i] - mu) * rs * A.ln_g[c0 + i] + A.ln_b[c0 + i]; o[i] = uf[i] * (w00 * vn[i] + b0); }
        *(f32x4*)(vs + c0) = (f32x4){vn[0], vn[1], vn[2], vn[3]}; *(f32x4*)(vs + c0 + 4) = (f32x4){vn[4], vn[5], vn[6], vn[7]};
        v4u w; w.x = pk2(o[0], o[1]); w.y = pk2(o[2], o[3]); w.z = pk2(o[4], o[5]); w.w = pk2(o[6], o[7]);
        *(v4u*)(A.MIXIN + row * DM + c0) = w; }
}

typedef short bf16x8 __attribute__((ext_vector_type(8)));
#define cvtpk_s pk2
#ifndef PROBE_SKIP_QS
#define PROBE_SKIP_QS 0
#endif
#define MFMA16(a, b, c) __builtin_amdgcn_mfma_f32_16x16x32_bf16((a), (b), (c), 0, 0, 0)
struct HgArgs { int l; bf16* PROJ; float* ZF; const float* LB; bf16* QF; bf16* KET; bf16* ITG; bf16* OI; float* DL; bf16* MIXIN; const float* gout; float* out; unsigned* flags; };
#define HG_RSRC(p, bytes) __builtin_amdgcn_make_buffer_rsrc((void*)(p), (short)0, (int)(bytes), 0x00020000)
template <int N> __device__ __forceinline__ void wait_flags(unsigned* f) {
    for (unsigned sp = 0u;; ) { unsigned ok = 1u;
#pragma unroll
        for (int i = 0; i < N; ++i) ok &= (__hip_atomic_load(f + i * 16, __ATOMIC_RELAXED, __HIP_MEMORY_SCOPE_AGENT) != 0u) ? 1u : 0u;
        if (ok) break; __builtin_amdgcn_s_sleep(4); if (++sp > (1u << 17)) break; }
    asm volatile("" ::: "memory");
}
__device__ __forceinline__ void wait_flag(unsigned* f) { unsigned sp = 0u; while (__hip_atomic_load(f, __ATOMIC_RELAXED, __HIP_MEMORY_SCOPE_AGENT) == 0u) { __builtin_amdgcn_s_sleep(4); if (++sp > (1u << 17)) break; } asm volatile("" ::: "memory"); }
constexpr int HG_QD = 0, HG_KD = 8704, HG_IT = 17408, HG_AT = 27648, HG_SEG = 30208, HG_KT = 32256, HG_DLS = 42496;
struct PreRegs { f32x4 z0, z1; v4u q, i;  float lb; };
constexpr int HG_ZL = 43008, HG_QL = 59392, HG_IL = 67584;
__device__ __forceinline__ void hgrn_pre_load(const HgArgs& A, int it, PreRegs& P, int tid) {
    const int bh = it >> 6, c = it & 63, b = bh >> 3, h = bh & 7, t = tid >> 4, kq = tid & 15; const size_t row = (size_t)(b * SEQ + 32 * c + t);
    const float* zp = A.ZF + row * 1024 + h * 128 + 8 * kq; P.z0 = *(const f32x4*)zp; P.z1 = *(const f32x4*)(zp + 4);
    P.q = *(const v4u*)(A.PROJ + row * INW + 2048 + h * 128 + 8 * kq); P.i = *(const v4u*)(A.PROJ + row * INW + 4096 + h * 128 + 8 * kq);
    P.lb = A.LB[A.l * 1024 + h * 128 + (tid & 127)];
}
__device__ __forceinline__ void hgrn_pre_item(const HgArgs& A, int it, int prev, int nxt, PreRegs& P, LAS unsigned char* lds, int tid) {
    const __amdgpu_buffer_rsrc_t rQF = HG_RSRC(A.QF, 16 << 20), rKE = HG_RSRC(A.KET, 16 << 20), rIT = HG_RSRC(A.ITG, 16 << 20), rOI = HG_RSRC(A.OI, 16 << 20);
    const int bh = it >> 6, c = it & 63, b = bh >> 3, h = bh & 7;
    const int m0 = b * SEQ + 32 * c;
    LAS bf16* QD = (LAS bf16*)(lds + HG_QD); LAS bf16* KD = (LAS bf16*)(lds + HG_KD); LAS bf16* IT = (LAS bf16*)(lds + HG_IT); LAS bf16* AT = (LAS bf16*)(lds + HG_AT); LAS float* SEG = (LAS float*)(lds + HG_SEG);
    const int k = tid & 127, seg = tid >> 7, lane = tid & 63, w = tid >> 6, fr = lane & 15, fq = lane >> 4;
    {   const int t = tid >> 4, kq = tid & 15;
        *(LAS f32x4*)(lds + HG_ZL + (t * 128 + 8 * kq) * 4) = P.z0; *(LAS f32x4*)(lds + HG_ZL + (t * 128 + 8 * kq + 4) * 4) = P.z1;
        *(LAS v4u*)(lds + HG_QL + (t * 128 + 8 * kq) * 2) = P.q; *(LAS v4u*)(lds + HG_IL + (t * 128 + 8 * kq) * 2) = P.i; }
    const float lbv = P.lb;
    if (nxt >= 0) hgrn_pre_load(A, nxt, P, tid);
    __syncthreads();
    float z[8], qv[8]; unsigned iv[8];
#pragma unroll
    for (int j = 0; j < 8; ++j) { const int tt = 8 * seg + j; z[j] = *(const LAS float*)(lds + HG_ZL + (tt * 128 + k) * 4);
        qv[j] = bf2f(*(const LAS unsigned short*)(lds + HG_QL + (tt * 128 + k) * 2)); iv[j] = *(const LAS unsigned short*)(lds + HG_IL + (tt * 128 + k) * 2); }
    float kk[8], cs[8]; float run = 0.f;
#pragma unroll
    for (int j = 0; j < 8; ++j) { const float sg = sigmoid_f(z[j]); const float f = lbv + (1.0f - lbv) * sg; kk[j] = (1.0f - lbv) * (1.0f - sg); run += fmaxf(__logf(f), -60.0f); cs[j] = run; }
    SEG[seg * 128 + k] = run;
    v4u ip; ip.x = iv[0] | (iv[1] << 16); ip.y = iv[2] | (iv[3] << 16); ip.z = iv[4] | (iv[5] << 16); ip.w = iv[6] | (iv[7] << 16);
    *(LAS v4u*)(IT + k * 40 + 8 * seg) = ip;
    __syncthreads();
    float off = 0.f, tot = 0.f;
#pragma unroll
    for (int s = 0; s < 4; ++s) { const float sv = SEG[s * 128 + k]; tot += sv; off += (s < seg) ? sv : 0.f; }
    float ke[8];
#pragma unroll
    for (int j = 0; j < 8; ++j) { const float bj = off + cs[j];
        const float qd = qv[j] * __expf(fmaxf(bj, -80.0f)), kd = kk[j] * __expf(fminf(-bj, 80.0f)); ke[j] = kk[j] * __expf(tot - bj);
        QD[(8 * seg + j) * 136 + k] = (bf16)(pk2(qd, 0.f) & 0xffffu); KD[(8 * seg + j) * 136 + k] = (bf16)(pk2(kd, 0.f) & 0xffffu); }
    { v4u kp; kp.x = pk2(ke[0], ke[1]); kp.y = pk2(ke[2], ke[3]); kp.z = pk2(ke[4], ke[5]); kp.w = pk2(ke[6], ke[7]);
      *(LAS v4u*)(lds + HG_KT + (k * 40 + 8 * seg) * 2) = kp; }
    if (seg == 0) *(LAS float*)(lds + HG_DLS + k * 4) = __expf(tot);
    __syncthreads();
    if (w < 3) {
        const int tt = (w > 0) ? 1 : 0, st = (w == 2) ? 1 : 0; f32x4 acc = (f32x4){0.f, 0.f, 0.f, 0.f};
#pragma unroll
        for (int kb = 0; kb < 4; ++kb) { const bf16x8 a = *(const LAS bf16x8*)(QD + (16 * tt + fr) * 136 + 32 * kb + 8 * fq), bq = *(const LAS bf16x8*)(KD + (16 * st + fr) * 136 + 32 * kb + 8 * fq); acc = MFMA16(a, bq, acc); }
#pragma unroll
        for (int r = 0; r < 4; ++r) { const int t = 16 * tt + 4 * fq + r, s = 16 * st + fr; AT[t * 40 + s] = (bf16)(pk2((s <= t) ? acc[r] : 0.f, 0.f) & 0xffffu); }
    } else if (w == 3) {
#pragma unroll
        for (int r = 0; r < 4; ++r) AT[(4 * fq + r) * 40 + 16 + fr] = (bf16)0;
    }
    v4u qfv;
    {
        const int tt = w >> 2, kb = w & 3;
        const v2u lo = *(const LAS v2u*)(QD + (16 * tt + fr) * 136 + 32 * kb + 4 * fq), hi = *(const LAS v2u*)(QD + (16 * tt + fr) * 136 + 32 * kb + 16 + 4 * fq);
        qfv = (v4u){lo.x, lo.y, hi.x, hi.y}; }
    __syncthreads();
    v4u oiv;
    {
        const bf16x8 a = *(const LAS bf16x8*)(IT + (16 * w + fr) * 40 + 8 * fq);
        const bf16x8 b0 = *(const LAS bf16x8*)(AT + fr * 40 + 8 * fq), b1 = *(const LAS bf16x8*)(AT + (16 + fr) * 40 + 8 * fq);
        const f32x4 zero = (f32x4){0.f, 0.f, 0.f, 0.f};
        const f32x4 o0 = MFMA16(a, b0, zero), o1 = MFMA16(a, b1, zero);
        oiv = (v4u){pk2(o0[0], o0[1]), pk2(o0[2], o0[3]), pk2(o1[0], o1[1]), pk2(o1[2], o1[3])}; }
    const v4u itl = *(const LAS v4u*)(IT + (tid >> 2) * 40 + (tid & 3) * 8), ktl = *(const LAS v4u*)(lds + HG_KT + ((tid >> 2) * 40 + (tid & 3) * 8) * 2);
    const v4u dll = *(const LAS v4u*)(lds + HG_DLS + (tid & 31) * 16);
    asm volatile("s_waitcnt vmcnt(0)" ::: "memory");
    __syncthreads();
    if (tid == 0 && prev >= 0) __hip_atomic_store(A.flags + (size_t)prev * 16, 1u, __ATOMIC_RELAXED, __HIP_MEMORY_SCOPE_AGENT);
    __builtin_amdgcn_raw_buffer_store_b128(itl, rIT, (unsigned)(it * 8192 + tid * 16), 0, 16);
    __builtin_amdgcn_raw_buffer_store_b128(ktl, rKE, (unsigned)(it * 8192 + tid * 16), 0, 16);
    if (tid < 32) __builtin_amdgcn_raw_buffer_store_b128(dll, HG_RSRC(A.DL, 2 << 20), (unsigned)(it * 1024 + tid * 16), 0, 16);
    __builtin_amdgcn_raw_buffer_store_b128(qfv, rQF, (unsigned)(((it * 8 + w) * 64 + lane) * 16), 0, 16);
    __builtin_amdgcn_raw_buffer_store_b128(oiv, rOI, (unsigned)(((it * 8 + w) * 64 + lane) * 16), 0, 16);
}
__device__ __forceinline__ void hgrn_pre_publish_last(const HgArgs& A, int last, int tid) {
    asm volatile("s_waitcnt vmcnt(0)" ::: "memory"); __syncthreads();
    if (tid == 0 && last >= 0) __hip_atomic_store(A.flags + (size_t)last * 16, 1u, __ATOMIC_RELAXED, __HIP_MEMORY_SCOPE_AGENT);
}
constexpr int SH_QF = 0, SH_KET = 8192, SH_DL = 16384, SH_BUF = 16896, SH_SS = 2 * SH_BUF;
struct ScanRegs { v4u qf, ke, it, oi, dl; v2u g0, g1; };
template <bool DRY> __device__ __forceinline__ void hgrn_scan_item(const HgArgs& A, int bh, LAS unsigned char* lds, int tid) {
    const int b = bh >> 3, h = bh & 7, lane = tid & 63, w = __builtin_amdgcn_readfirstlane(tid >> 6), fr = lane & 15, fq = lane >> 4;
    LAS float* SS = (LAS float*)(lds + SH_SS);
    f32x4 S[8];
#pragma unroll
    for (int kt = 0; kt < 8; ++kt) S[kt] = (f32x4){0.f, 0.f, 0.f, 0.f};
    const f32x4 go = *(const f32x4*)(A.gout + h * 128 + 16 * w + 4 * fq);
    const size_t it0 = (size_t)bh * 64;
    const __amdgpu_buffer_rsrc_t rQF = HG_RSRC(A.QF, 16 << 20), rKE = HG_RSRC(A.KET, 16 << 20), rIT = HG_RSRC(A.ITG, 16 << 20), rOI = HG_RSRC(A.OI, 16 << 20), rDL = HG_RSRC(A.DL, 2 << 20);
    const unsigned oQF = (unsigned)(((it0 * 8 + w) * 64 + lane) * 16), oKE = (unsigned)(((it0 * 128 + 16 * w + fr) * 32 + 8 * fq) * 2), oDL = (unsigned)((it0 * 256 + 4 * (lane & 31)) * 4);
    const v2u* pG = (const v2u*)(A.PROJ + (size_t)(b * SEQ + fr) * INW + 5120 + h * 128 + 16 * w + 4 * fq);
    unsigned* fl = A.flags + it0 * 16;
#define SC_LOAD(R, cc) do { const unsigned _c = (unsigned)(cc); wait_flag(fl + _c * 16); \
        R.qf = __builtin_amdgcn_raw_buffer_load_b128(rQF, oQF + _c * 8192u, 0, 16); R.ke = __builtin_amdgcn_raw_buffer_load_b128(rKE, oKE + _c * 8192u, 0, 16); \
        R.it = __builtin_amdgcn_raw_buffer_load_b128(rIT, oKE + _c * 8192u, 0, 16); R.oi = __builtin_amdgcn_raw_buffer_load_b128(rOI, oQF + _c * 8192u, 0, 16); \
        R.g0 = pG[(size_t)_c * 49152]; R.g1 = pG[(size_t)_c * 49152 + 24576]; if (w == 0) R.dl = __builtin_amdgcn_raw_buffer_load_b128(rDL, oDL + _c * 1024u, 0, 16); } while (0)
    ScanRegs A0, A1, B0, B1;
#define SC_DRAIN(R) asm volatile("" : "+v"(R.qf), "+v"(R.ke), "+v"(R.it), "+v"(R.oi), "+v"(R.dl), "+v"(R.g0), "+v"(R.g1))
    A0.dl = (v4u){0u, 0u, 0u, 0u}; A1.dl = A0.dl; B0.dl = A0.dl; B1.dl = A0.dl;
    SC_LOAD(A0, 0); SC_LOAD(A1, 1); SC_LOAD(B0, 2); SC_LOAD(B1, 3);
    SC_DRAIN(A0); SC_DRAIN(A1); SC_DRAIN(B0); SC_DRAIN(B1);
    f32x4 og0 = (f32x4){0.f, 0.f, 0.f, 0.f}, og1 = (f32x4){0.f, 0.f, 0.f, 0.f};
#define SC_STEP(R, cc) do { const int c = (cc); \
        LAS unsigned char* shb = lds + (c & 1) * SH_BUF; \
        *(LAS v4u*)(shb + SH_QF + w * 1024 + lane * 16) = R.qf; *(LAS v4u*)(shb + SH_KET + w * 1024 + lane * 16) = R.ke; \
        if (w == 0 && lane < 32) *(LAS v4u*)(shb + SH_DL + lane * 16) = R.dl; \
        const v4u itv = R.it, oi = R.oi; const v2u g0 = R.g0, g1 = R.g1; \
        __syncthreads(); \
        if (c > 0) { const LAS float* ss = SS + ((c - 1) & 1) * 256; float s0 = 0.f, s1 = 0.f; \
            _Pragma("unroll") for (int g = 0; g < 8; ++g) { s0 += ss[g * 32 + fr]; s1 += ss[g * 32 + 16 + fr]; } \
            const float r0 = __builtin_amdgcn_rsqf(s0 * (1.0f / 128.0f) + EPS), r1 = __builtin_amdgcn_rsqf(s1 * (1.0f / 128.0f) + EPS); \
            const size_t row = (size_t)(b * SEQ + 32 * (c - 1) + fr); \
            *(v2u*)(A.MIXIN + row * DM + 1024 + h * 128 + 16 * w + 4 * fq) = (v2u){pk2(og0[0] * r0, og0[1] * r0), pk2(og0[2] * r0, og0[3] * r0)}; \
            *(v2u*)(A.MIXIN + (row + 16) * DM + 1024 + h * 128 + 16 * w + 4 * fq) = (v2u){pk2(og1[0] * r1, og1[1] * r1), pk2(og1[2] * r1, og1[3] * r1)}; } \
        bf16x8 qf[8]; \
        _Pragma("unroll") for (int i = 0; i < 8; ++i) qf[i] = *(const LAS bf16x8*)(shb + SH_QF + i * 1024 + lane * 16); \
        if (!DRY) asm volatile("" ::: "memory"); \
        f32x4 o0 = (f32x4){bflo(oi.x), bfhi(oi.x), bflo(oi.y), bfhi(oi.y)}, o1 = (f32x4){bflo(oi.z), bfhi(oi.z), bflo(oi.w), bfhi(oi.w)}; \
        _Pragma("unroll") for (int kb = 0; kb < 4; ++kb) { \
            const v4u sp = (v4u){pk2(S[2 * kb][0], S[2 * kb][1]), pk2(S[2 * kb][2], S[2 * kb][3]), pk2(S[2 * kb + 1][0], S[2 * kb + 1][1]), pk2(S[2 * kb + 1][2], S[2 * kb + 1][3])}; \
            const bf16x8 sa = __builtin_bit_cast(bf16x8, sp); \
            o0 = MFMA16(sa, qf[kb], o0); o1 = MFMA16(sa, qf[4 + kb], o1); } \
        { float p0 = (o0[0] * o0[0] + o0[1] * o0[1]) + (o0[2] * o0[2] + o0[3] * o0[3]), p1 = (o1[0] * o1[0] + o1[1] * o1[1]) + (o1[2] * o1[2] + o1[3] * o1[3]); \
            p0 += __shfl_xor(p0, 16); p0 += __shfl_xor(p0, 32); p1 += __shfl_xor(p1, 16); p1 += __shfl_xor(p1, 32); \
            LAS float* ssw = SS + (c & 1) * 256 + w * 32; if (fq == 0) { ssw[fr] = p0; ssw[16 + fr] = p1; } \
            og0 = (f32x4){o0[0] * go[0] * bflo(g0.x), o0[1] * go[1] * bfhi(g0.x), o0[2] * go[2] * bflo(g0.y), o0[3] * go[3] * bfhi(g0.y)}; \
            og1 = (f32x4){o1[0] * go[0] * bflo(g1.x), o1[1] * go[1] * bfhi(g1.x), o1[2] * go[2] * bflo(g1.y), o1[3] * go[3] * bfhi(g1.y)}; } \
        const bf16x8 ib = __builtin_bit_cast(bf16x8, itv); \
        _Pragma("unroll") for (int kt = 0; kt < 8; ++kt) { \
            const f32x4 d4 = *(const LAS f32x4*)(shb + SH_DL + (16 * kt + 4 * fq) * 4); \
            const bf16x8 ka = *(const LAS bf16x8*)(shb + SH_KET + kt * 1024 + lane * 16); \
            S[kt] = MFMA16(ka, ib, S[kt] * d4); } \
    } while (0)
    for (int c0 = 0; c0 < 64; c0 += 8) {
        SC_STEP(A0, c0); SC_STEP(A1, c0 + 1);
        SC_LOAD(A0, c0 + 4); SC_LOAD(A1, c0 + 5);
        SC_STEP(B0, c0 + 2); SC_STEP(B1, c0 + 3);
        SC_LOAD(B0, c0 + 6); SC_LOAD(B1, c0 + 7);
        SC_STEP(A0, c0 + 4); SC_STEP(A1, c0 + 5);
        if (c0 + 8 < 64) { SC_LOAD(A0, c0 + 8); SC_LOAD(A1, c0 + 9); }
        SC_STEP(B0, c0 + 6); SC_STEP(B1, c0 + 7);
        if (c0 + 8 < 64) { SC_LOAD(B0, c0 + 10); SC_LOAD(B1, c0 + 11); }
        SC_DRAIN(A0); SC_DRAIN(A1); SC_DRAIN(B0); SC_DRAIN(B1);
    }
    __syncthreads();
    {   const LAS float* ss = SS + (63 & 1) * 256;
        float s0 = 0.f, s1 = 0.f;
#pragma unroll
        for (int g = 0; g < 8; ++g) { s0 += ss[g * 32 + fr]; s1 += ss[g * 32 + 16 + fr]; }
        const float r0 = __builtin_amdgcn_rsqf(s0 * (1.0f / 128.0f) + EPS), r1 = __builtin_amdgcn_rsqf(s1 * (1.0f / 128.0f) + EPS);
        const size_t row = (size_t)(b * SEQ + 32 * 63 + fr);
        *(v2u*)(A.MIXIN + row * DM + 1024 + h * 128 + 16 * w + 4 * fq) = (v2u){pk2(og0[0] * r0, og0[1] * r0), pk2(og0[2] * r0, og0[3] * r0)};
        *(v2u*)(A.MIXIN + (row + 16) * DM + 1024 + h * 128 + 16 * w + 4 * fq) = (v2u){pk2(og1[0] * r1, og1[1] * r1), pk2(og1[2] * r1, og1[3] * r1)}; }
    float* sp = A.out + OUT_SP + ((size_t)((A.l * NB + b) * 8 + h) * 128) * 128;
#pragma unroll
    for (int kt = 0; kt < 8; ++kt)
#pragma unroll
        for (int r = 0; r < 4; ++r) sp[(size_t)(16 * kt + 4 * fq + r) * 128 + 16 * w + fr] = S[kt][r];
    __syncthreads();
#undef SC_LOAD
#undef SC_STEP
}
constexpr int S2_QF = 0, S2_KET = 8192, S2_DL = 16384, S2_BUF = 16896, S2_SF = 2 * S2_BUF, S2_SS = S2_SF + 2 * 32768;
struct ScanRegs2 { v4u qf, ke, a0, a1, dl; v2u g00, g01, g10, g11; };
__device__ __forceinline__ void hgrn_scan_item2(const HgArgs& A, int bh, LAS unsigned char* lds, int tid) {
    const int b = bh >> 3, h = bh & 7, lane = tid & 63, w = __builtin_amdgcn_readfirstlane(tid >> 6), fr = lane & 15, fq = lane >> 4;
    const bool srole = w < 4; const int k2 = w & 3, vt0 = 2 * k2, vt1 = 2 * k2 + 1;
    LAS float* SS = (LAS float*)(lds + S2_SS);
    f32x4 X[16];
#pragma unroll
    for (int kt = 0; kt < 16; ++kt) X[kt] = (f32x4){0.f, 0.f, 0.f, 0.f};
    const f32x4 go0 = *(const f32x4*)(A.gout + h * 128 + 16 * vt0 + 4 * fq), go1 = *(const f32x4*)(A.gout + h * 128 + 16 * vt1 + 4 * fq);
    const size_t it0 = (size_t)bh * 64;
    const __amdgpu_buffer_rsrc_t rQF = HG_RSRC(A.QF, 16 << 20), rKE = HG_RSRC(A.KET, 16 << 20), rIT = HG_RSRC(A.ITG, 16 << 20), rOI = HG_RSRC(A.OI, 16 << 20), rDL = HG_RSRC(A.DL, 2 << 20);
    const unsigned oQF = (unsigned)(((it0 * 8 + w) * 64 + lane) * 16), oKE = (unsigned)(((it0 * 128 + 16 * w + fr) * 32 + 8 * fq) * 2), oDL = (unsigned)((it0 * 256 + 4 * (lane & 31)) * 4);
    const unsigned oIT0 = (unsigned)(((it0 * 128 + 16 * vt0 + fr) * 32 + 8 * fq) * 2), oOI0 = (unsigned)(((it0 * 8 + vt0) * 64 + lane) * 16);
    const v2u* pG = (const v2u*)(A.PROJ + (size_t)(b * SEQ + fr) * INW + 5120 + h * 128 + 16 * vt0 + 4 * fq);
    unsigned* fl = A.flags + it0 * 16;
#define S2_LOAD(R, cc) do { const unsigned _c = (unsigned)(cc); \
        R.qf = __builtin_amdgcn_raw_buffer_load_b128(rQF, oQF + _c * 8192u, 0, 16); R.ke = __builtin_amdgcn_raw_buffer_load_b128(rKE, oKE + _c * 8192u, 0, 16); \
        if (w == 0) R.dl = __builtin_amdgcn_raw_buffer_load_b128(rDL, oDL + _c * 1024u, 0, 16); \
        if (srole) { R.a0 = __builtin_amdgcn_raw_buffer_load_b128(rIT, oIT0 + _c * 8192u, 0, 16); R.a1 = __builtin_amdgcn_raw_buffer_load_b128(rIT, oIT0 + 1024u + _c * 8192u, 0, 16); } \
        else { R.a0 = __builtin_amdgcn_raw_buffer_load_b128(rOI, oOI0 + _c * 8192u, 0, 16); R.a1 = __builtin_amdgcn_raw_buffer_load_b128(rOI, oOI0 + 1024u + _c * 8192u, 0, 16); \
               const v2u* _g = pG + (size_t)_c * 49152; R.g00 = _g[0]; R.g01 = _g[24576]; R.g10 = _g[4]; R.g11 = _g[24580]; } } while (0)
#define S2_DRAIN(R) asm volatile("" : "+v"(R.qf), "+v"(R.ke), "+v"(R.a0), "+v"(R.a1), "+v"(R.dl), "+v"(R.g00), "+v"(R.g01), "+v"(R.g10), "+v"(R.g11))
    ScanRegs2 RA, RB, RC;
    { const v4u z4 = (v4u){0u, 0u, 0u, 0u}; const v2u z2 = (v2u){0u, 0u};
      RA.dl = z4; RB.dl = z4; RC.dl = z4; RA.g00 = z2; RA.g01 = z2; RA.g10 = z2; RA.g11 = z2; RB.g00 = z2; RB.g01 = z2; RB.g10 = z2; RB.g11 = z2; RC.g00 = z2; RC.g01 = z2; RC.g10 = z2; RC.g11 = z2; }
    wait_flags<3>(fl);
    S2_LOAD(RA, 0); S2_LOAD(RB, 1); S2_LOAD(RC, 2);
    S2_DRAIN(RA); S2_DRAIN(RB); S2_DRAIN(RC);
#define S2_FINISH(cp) do { const LAS float* ss = SS + ((cp) & 1) * 128; float s0 = 0.f, s1 = 0.f; \
        _Pragma("unroll") for (int g = 0; g < 4; ++g) { s0 += ss[g * 32 + fr]; s1 += ss[g * 32 + 16 + fr]; } \
        const float r0 = __builtin_amdgcn_rsqf(s0 * (1.0f / 128.0f) + EPS), r1 = __builtin_amdgcn_rsqf(s1 * (1.0f / 128.0f) + EPS); \
        bf16* orow = A.MIXIN + (size_t)(b * SEQ + 32 * (cp) + fr) * DM + 1024 + h * 128 + 16 * vt0 + 4 * fq; \
        *(v2u*)(orow) = (v2u){pk2(X[0][0] * r0, X[0][1] * r0), pk2(X[0][2] * r0, X[0][3] * r0)}; *(v2u*)(orow + 16) = (v2u){pk2(X[2][0] * r0, X[2][1] * r0), pk2(X[2][2] * r0, X[2][3] * r0)}; \
        *(v2u*)(orow + (size_t)16 * DM) = (v2u){pk2(X[1][0] * r1, X[1][1] * r1), pk2(X[1][2] * r1, X[1][3] * r1)}; *(v2u*)(orow + (size_t)16 * DM + 16) = (v2u){pk2(X[3][0] * r1, X[3][1] * r1), pk2(X[3][2] * r1, X[3][3] * r1)}; } while (0)
#define S2_STEP(R, cc) do { const int c = (cc); \
        LAS unsigned char* shb = lds + (c & 1) * S2_BUF; \
        *(LAS v4u*)(shb + S2_QF + w * 1024 + lane * 16) = R.qf; *(LAS v4u*)(shb + S2_KET + w * 1024 + lane * 16) = R.ke; \
        if (w == 0 && lane < 32) *(LAS v4u*)(shb + S2_DL + lane * 16) = R.dl; \
        const v4u a0 = R.a0, a1 = R.a1; const v2u g00 = R.g00, g01 = R.g01, g10 = R.g10, g11 = R.g11; \
        __syncthreads(); \
        if (srole) { \
            const bf16x8 ib0 = __builtin_bit_cast(bf16x8, a0), ib1 = __builtin_bit_cast(bf16x8, a1); \
            _Pragma("unroll") for (int kt = 0; kt < 8; ++kt) { \
                const f32x4 d4 = *(const LAS f32x4*)(shb + S2_DL + (16 * kt + 4 * fq) * 4); \
                const bf16x8 ka = *(const LAS bf16x8*)(shb + S2_KET + kt * 1024 + lane * 16); \
                X[kt] = MFMA16(ka, ib0, X[kt] * d4); X[8 + kt] = MFMA16(ka, ib1, X[8 + kt] * d4); } \
            LAS unsigned char* sf = lds + S2_SF + ((c + 1) & 1) * 32768 + lane * 16; \
            _Pragma("unroll") for (int kb = 0; kb < 4; ++kb) { \
                *(LAS v4u*)(sf + (vt0 * 4 + kb) * 1024) = (v4u){pk2(X[2 * kb][0], X[2 * kb][1]), pk2(X[2 * kb][2], X[2 * kb][3]), pk2(X[2 * kb + 1][0], X[2 * kb + 1][1]), pk2(X[2 * kb + 1][2], X[2 * kb + 1][3])}; \
                *(LAS v4u*)(sf + (vt1 * 4 + kb) * 1024) = (v4u){pk2(X[8 + 2 * kb][0], X[8 + 2 * kb][1]), pk2(X[8 + 2 * kb][2], X[8 + 2 * kb][3]), pk2(X[8 + 2 * kb + 1][0], X[8 + 2 * kb + 1][1]), pk2(X[8 + 2 * kb + 1][2], X[8 + 2 * kb + 1][3])}; } \
        } else { \
            if (c > 0) S2_FINISH(c - 1); \
            f32x4 o00 = (f32x4){bflo(a0.x), bfhi(a0.x), bflo(a0.y), bfhi(a0.y)}, o01 = (f32x4){bflo(a0.z), bfhi(a0.z), bflo(a0.w), bfhi(a0.w)}; \
            f32x4 o10 = (f32x4){bflo(a1.x), bfhi(a1.x), bflo(a1.y), bfhi(a1.y)}, o11 = (f32x4){bflo(a1.z), bfhi(a1.z), bflo(a1.w), bfhi(a1.w)}; \
            if (c > 0) { const LAS unsigned char* sf = lds + S2_SF + (c & 1) * 32768 + lane * 16; \
                _Pragma("unroll") for (int kb = 0; kb < 4; ++kb) { \
                    const bf16x8 sa0 = *(const LAS bf16x8*)(sf + (vt0 * 4 + kb) * 1024), sa1 = *(const LAS bf16x8*)(sf + (vt1 * 4 + kb) * 1024); \
                    const bf16x8 q0 = *(const LAS bf16x8*)(shb + S2_QF + kb * 1024 + lane * 16), q1 = *(const LAS bf16x8*)(shb + S2_QF + (4 + kb) * 1024 + lane * 16); \
                    o00 = MFMA16(sa0, q0, o00); o01 = MFMA16(sa0, q1, o01); o10 = MFMA16(sa1, q0, o10); o11 = MFMA16(sa1, q1, o11); } } \
            float p0 = ((o00[0] * o00[0] + o00[1] * o00[1]) + (o00[2] * o00[2] + o00[3] * o00[3])) + ((o10[0] * o10[0] + o10[1] * o10[1]) + (o10[2] * o10[2] + o10[3] * o10[3])); \
            float p1 = ((o01[0] * o01[0] + o01[1] * o01[1]) + (o01[2] * o01[2] + o01[3] * o01[3])) + ((o11[0] * o11[0] + o11[1] * o11[1]) + (o11[2] * o11[2] + o11[3] * o11[3])); \
            p0 += __shfl_xor(p0, 16); p0 += __shfl_xor(p0, 32); p1 += __shfl_xor(p1, 16); p1 += __shfl_xor(p1, 32); \
            LAS float* ssw = SS + (c & 1) * 128 + k2 * 32; if (fq == 0) { ssw[fr] = p0; ssw[16 + fr] = p1; } \
            X[0] = (f32x4){o00[0] * go0[0] * bflo(g00.x), o00[1] * go0[1] * bfhi(g00.x), o00[2] * go0[2] * bflo(g00.y), o00[3] * go0[3] * bfhi(g00.y)}; \
            X[1] = (f32x4){o01[0] * go0[0] * bflo(g01.x), o01[1] * go0[1] * bfhi(g01.x), o01[2] * go0[2] * bflo(g01.y), o01[3] * go0[3] * bfhi(g01.y)}; \
            X[2] = (f32x4){o10[0] * go1[0] * bflo(g10.x), o10[1] * go1[1] * bfhi(g10.x), o10[2] * go1[2] * bflo(g10.y), o10[3] * go1[3] * bfhi(g10.y)}; \
            X[3] = (f32x4){o11[0] * go1[0] * bflo(g11.x), o11[1] * go1[1] * bfhi(g11.x), o11[2] * go1[2] * bflo(g11.y), o11[3] * go1[3] * bfhi(g11.y)}; \
        } \
    } while (0)
    for (int c0 = 0; c0 < 60; c0 += 6) {
        wait_flags<6>(fl + (c0 + 3) * 16);
        S2_STEP(RA, c0); S2_LOAD(RA, c0 + 3);
        S2_STEP(RB, c0 + 1); S2_LOAD(RB, c0 + 4);
        S2_STEP(RC, c0 + 2); S2_LOAD(RC, c0 + 5);
        S2_STEP(RA, c0 + 3); S2_LOAD(RA, c0 + 6);
        S2_STEP(RB, c0 + 4); S2_LOAD(RB, c0 + 7);
        S2_STEP(RC, c0 + 5); S2_LOAD(RC, c0 + 8);
        S2_DRAIN(RA); S2_DRAIN(RB); S2_DRAIN(RC);
    }
    wait_flags<1>(fl + 63 * 16);
    S2_STEP(RA, 60); S2_LOAD(RA, 63); S2_STEP(RB, 61); S2_STEP(RC, 62); S2_DRAIN(RA); S2_STEP(RA, 63);
    __syncthreads();
    if (!srole) S2_FINISH(63);
    else { float* sp = A.out + OUT_SP + ((size_t)((A.l * NB + b) * 8 + h) * 128) * 128;
#pragma unroll
        for (int kt = 0; kt < 8; ++kt)
#pragma unroll
            for (int r = 0; r < 4; ++r) { sp[(size_t)(16 * kt + 4 * fq + r) * 128 + 16 * vt0 + fr] = X[kt][r]; sp[(size_t)(16 * kt + 4 * fq + r) * 128 + 16 * vt1 + fr] = X[8 + kt][r]; } }
    __syncthreads();
#undef S2_LOAD
#undef S2_DRAIN
#undef S2_FINISH
#undef S2_STEP
}
template <int N> __device__ __forceinline__ void wait_flags_clamped(unsigned* fl, int first) {
    for (unsigned sp = 0u;; ) { unsigned ok = 1u;
#pragma unroll
        for (int i = 0; i < N; ++i) { const int c = (first + i < 63) ? first + i : 63; ok &= (__hip_atomic_load(fl + c * 16, __ATOMIC_RELAXED, __HIP_MEMORY_SCOPE_AGENT) != 0u) ? 1u : 0u; }
        if (ok) break; __builtin_amdgcn_s_sleep(4); if (++sp > (1u << 17)) break; }
    asm volatile("" ::: "memory");
}
struct S3RegS { v4u f0, f1, a0, a1, dl; };
struct S3RegO { v4u f0, f1, a0, a1, gA, gB; };
constexpr int S3_G = S2_SS + 1024, S3_GROW = 272;
template <bool POLL> __device__ __forceinline__ void hgrn_scan_item3(const HgArgs& A, int bh, LAS unsigned char* lds, int tid) {
    const int b = bh >> 3, h = bh & 7, lane = tid & 63, w = __builtin_amdgcn_readfirstlane(tid >> 6), fr = lane & 15, fq = lane >> 4;
    const int k2 = w & 3, vt0 = 2 * k2, vt1 = 2 * k2 + 1;
    LAS float* SS = (LAS float*)(lds + S2_SS);
    const size_t it0 = (size_t)bh * 64;
    unsigned* fl = A.flags + it0 * 16;
#define S3_CL(cc) ((unsigned)(((cc) < 63) ? (cc) : 63))
#define S3_FLD(cc) __hip_atomic_load(fl + S3_CL(cc) * 16, __ATOMIC_RELAXED, __HIP_MEMORY_SCOPE_AGENT)
#define S3_FCHK(F, cc) do { if (__builtin_amdgcn_readfirstlane(F) == 0u) { unsigned _sp = 0u; while (S3_FLD(cc) == 0u) { __builtin_amdgcn_s_sleep(2); if (++_sp > (1u << 17)) break; } } asm volatile("" ::: "memory"); } while (0)
    if (w < 4) {
        const __amdgpu_buffer_rsrc_t rKE = HG_RSRC(A.KET, 16 << 20), rIT = HG_RSRC(A.ITG, 16 << 20), rDL = HG_RSRC(A.DL, 2 << 20);
        const unsigned oK = (unsigned)(((it0 * 128 + 16 * vt0 + fr) * 32 + 8 * fq) * 2), oDL = (unsigned)((it0 * 256 + 4 * (lane & 31)) * 4);
        f32x4 X[16];
#pragma unroll
        for (int kt = 0; kt < 16; ++kt) X[kt] = (f32x4){0.f, 0.f, 0.f, 0.f};
        S3RegS R[6];
#define S3S_LOAD(i, cc) do { const unsigned _o = S3_CL(cc) * 8192u; \
            R[i].f0 = __builtin_amdgcn_raw_buffer_load_b128(rKE, oK + _o, 0, 16); R[i].f1 = __builtin_amdgcn_raw_buffer_load_b128(rKE, oK + 1024u + _o, 0, 16); \
            R[i].a0 = __builtin_amdgcn_raw_buffer_load_b128(rIT, oK + _o, 0, 16); R[i].a1 = __builtin_amdgcn_raw_buffer_load_b128(rIT, oK + 1024u + _o, 0, 16); \
            R[i].dl = __builtin_amdgcn_raw_buffer_load_b128(rDL, oDL + S3_CL(cc) * 1024u, 0, 16); } while (0)
#define S3S_STEP(i, cc) do { const int c = (cc); \
            LAS unsigned char* shb = lds + (c & 1) * S2_BUF; \
            *(LAS v4u*)(shb + S2_KET + vt0 * 1024 + lane * 16) = R[i].f0; *(LAS v4u*)(shb + S2_KET + vt1 * 1024 + lane * 16) = R[i].f1; \
            if (w == 0 && lane < 32) *(LAS v4u*)(shb + S2_DL + lane * 16) = R[i].dl; \
            const bf16x8 ib0 = __builtin_bit_cast(bf16x8, R[i].a0), ib1 = __builtin_bit_cast(bf16x8, R[i].a1); \
            __syncthreads(); \
            _Pragma("unroll") for (int kt = 0; kt < 8; ++kt) { \
                const f32x4 d4 = *(const LAS f32x4*)(shb + S2_DL + (16 * kt + 4 * fq) * 4); \
                const bf16x8 ka = *(const LAS bf16x8*)(shb + S2_KET + kt * 1024 + lane * 16); \
                X[kt] = MFMA16(ka, ib0, X[kt] * d4); X[8 + kt] = MFMA16(ka, ib1, X[8 + kt] * d4); } \
            LAS unsigned char* sf = lds + S2_SF + ((c + 1) & 1) * 32768 + lane * 16; \
            _Pragma("unroll") for (int kb = 0; kb < 4; ++kb) { \
                *(LAS v4u*)(sf + (vt0 * 4 + kb) * 1024) = (v4u){pk2(X[2 * kb][0], X[2 * kb][1]), pk2(X[2 * kb][2], X[2 * kb][3]), pk2(X[2 * kb + 1][0], X[2 * kb + 1][1]), pk2(X[2 * kb + 1][2], X[2 * kb + 1][3])}; \
                *(LAS v4u*)(sf + (vt1 * 4 + kb) * 1024) = (v4u){pk2(X[8 + 2 * kb][0], X[8 + 2 * kb][1]), pk2(X[8 + 2 * kb][2], X[8 + 2 * kb][3]), pk2(X[8 + 2 * kb + 1][0], X[8 + 2 * kb + 1][1]), pk2(X[8 + 2 * kb + 1][2], X[8 + 2 * kb + 1][3])}; } \
        } while (0)
#define S3S_SL(s) do { S3S_STEP((s) % 6, c0 + (s)); if (POLL) S3_FCHK(F[(s) % 3], c0 + (s) + 6); S3S_LOAD((s) % 6, c0 + (s) + 6); if (POLL) F[(s) % 3] = S3_FLD(c0 + (s) + 9); } while (0)
#define S3S_TRIP(cb) do { const int c0 = (cb); S3S_SL(0); S3S_SL(1); S3S_SL(2); S3S_SL(3); S3S_SL(4); S3S_SL(5); S3S_SL(6); S3S_SL(7); S3S_SL(8); S3S_SL(9); S3S_SL(10); S3S_SL(11); } while (0)
        unsigned F[3] = {1u, 1u, 1u};
        if (POLL) { wait_flags_clamped<6>(fl, 0); F[0] = S3_FLD(6); F[1] = S3_FLD(7); F[2] = S3_FLD(8); }
        S3S_LOAD(0, 0); S3S_LOAD(1, 1); S3S_LOAD(2, 2); S3S_LOAD(3, 3); S3S_LOAD(4, 4); S3S_LOAD(5, 5);
        S3S_TRIP(0); S3S_TRIP(12); S3S_TRIP(24); S3S_TRIP(36); S3S_TRIP(48);
        S3S_STEP(0, 60); S3S_STEP(1, 61); S3S_STEP(2, 62); S3S_STEP(3, 63);
        __syncthreads();
        float* sp = A.out + OUT_SP + ((size_t)((A.l * NB + b) * 8 + h) * 128) * 128;
#pragma unroll
        for (int kt = 0; kt < 8; ++kt)
#pragma unroll
            for (int r = 0; r < 4; ++r) { sp[(size_t)(16 * kt + 4 * fq + r) * 128 + 16 * vt0 + fr] = X[kt][r]; sp[(size_t)(16 * kt + 4 * fq + r) * 128 + 16 * vt1 + fr] = X[8 + kt][r]; }
        __syncthreads();
#undef S3S_LOAD
#undef S3S_STEP
#undef S3S_SL
#undef S3S_TRIP
    } else {
        const __amdgpu_buffer_rsrc_t rQF = HG_RSRC(A.QF, 16 << 20), rOI = HG_RSRC(A.OI, 16 << 20);
        const unsigned oQ = (unsigned)(((it0 * 8 + vt0) * 64 + lane) * 16);
        const char* pG = (const char*)(A.PROJ + (size_t)(b * SEQ + 8 * k2 + (lane >> 4)) * INW + 5120 + h * 128) + (lane & 15) * 16;
        const f32x4 go0 = *(const f32x4*)(A.gout + h * 128 + 16 * vt0 + 4 * fq), go1 = *(const f32x4*)(A.gout + h * 128 + 16 * vt1 + 4 * fq);
        f32x4 og00 = (f32x4){0.f, 0.f, 0.f, 0.f}, og01 = og00, og10 = og00, og11 = og00;
        S3RegO R[6];
#define S3O_LOAD(i, cc) do { const unsigned _o = S3_CL(cc) * 8192u; const char* _g = pG + (size_t)S3_CL(cc) * (32 * INW * 2); \
            R[i].f0 = __builtin_amdgcn_raw_buffer_load_b128(rQF, oQ + _o, 0, 16); R[i].f1 = __builtin_amdgcn_raw_buffer_load_b128(rQF, oQ + 1024u + _o, 0, 16); \
            R[i].a0 = __builtin_amdgcn_raw_buffer_load_b128(rOI, oQ + _o, 0, 16); R[i].a1 = __builtin_amdgcn_raw_buffer_load_b128(rOI, oQ + 1024u + _o, 0, 16); \
            R[i].gA = *(const v4u*)_g; R[i].gB = *(const v4u*)(_g + 4 * INW * 2); } while (0)
#define S3O_FINISH(cp) do { const LAS float* ss = SS + ((cp) & 1) * 128; float s0 = 0.f, s1 = 0.f; \
            _Pragma("unroll") for (int g = 0; g < 4; ++g) { s0 += ss[g * 32 + fr]; s1 += ss[g * 32 + 16 + fr]; } \
            const float r0 = __builtin_amdgcn_rsqf(s0 * (1.0f / 128.0f) + EPS), r1 = __builtin_amdgcn_rsqf(s1 * (1.0f / 128.0f) + EPS); \
            bf16* orow = A.MIXIN + (size_t)(b * SEQ + 32 * (cp) + fr) * DM + 1024 + h * 128 + 16 * vt0 + 4 * fq; \
            *(v2u*)(orow) = (v2u){pk2(og00[0] * r0, og00[1] * r0), pk2(og00[2] * r0, og00[3] * r0)}; *(v2u*)(orow + 16) = (v2u){pk2(og10[0] * r0, og10[1] * r0), pk2(og10[2] * r0, og10[3] * r0)}; \
            *(v2u*)(orow + (size_t)16 * DM) = (v2u){pk2(og01[0] * r1, og01[1] * r1), pk2(og01[2] * r1, og01[3] * r1)}; *(v2u*)(orow + (size_t)16 * DM + 16) = (v2u){pk2(og11[0] * r1, og11[1] * r1), pk2(og11[2] * r1, og11[3] * r1)}; } while (0)
#define S3O_STEP(i, cc) do { const int c = (cc); \
            LAS unsigned char* shb = lds + (c & 1) * S2_BUF; \
            *(LAS v4u*)(shb + S2_QF + vt0 * 1024 + lane * 16) = R[i].f0; *(LAS v4u*)(shb + S2_QF + vt1 * 1024 + lane * 16) = R[i].f1; \
            { LAS unsigned char* gw = lds + S3_G + (c & 1) * (32 * S3_GROW) + (8 * k2 + (lane >> 4)) * S3_GROW + (lane & 15) * 16; *(LAS v4u*)gw = R[i].gA; *(LAS v4u*)(gw + 4 * S3_GROW) = R[i].gB; } \
            const v4u a0 = R[i].a0, a1 = R[i].a1; \
            __syncthreads(); \
            const LAS unsigned char* gr = lds + S3_G + (c & 1) * (32 * S3_GROW) + fr * S3_GROW + (16 * vt0 + 4 * fq) * 2; \
            const v2u g00 = *(const LAS v2u*)gr, g01 = *(const LAS v2u*)(gr + 16 * S3_GROW), g10 = *(const LAS v2u*)(gr + 32), g11 = *(const LAS v2u*)(gr + 16 * S3_GROW + 32); \
            if (c > 0) S3O_FINISH(c - 1); \
            f32x4 o00 = (f32x4){bflo(a0.x), bfhi(a0.x), bflo(a0.y), bfhi(a0.y)}, o01 = (f32x4){bflo(a0.z), bfhi(a0.z), bflo(a0.w), bfhi(a0.w)}; \
            f32x4 o10 = (f32x4){bflo(a1.x), bfhi(a1.x), bflo(a1.y), bfhi(a1.y)}, o11 = (f32x4){bflo(a1.z), bfhi(a1.z), bflo(a1.w), bfhi(a1.w)}; \
            if (c > 0) { const LAS unsigned char* sf = lds + S2_SF + (c & 1) * 32768 + lane * 16; \
                _Pragma("unroll") for (int kb = 0; kb < 4; ++kb) { \
                    const bf16x8 sa0 = *(const LAS bf16x8*)(sf + (vt0 * 4 + kb) * 1024), sa1 = *(const LAS bf16x8*)(sf + (vt1 * 4 + kb) * 1024); \
                    const bf16x8 q0 = *(const LAS bf16x8*)(shb + S2_QF + kb * 1024 + lane * 16), q1 = *(const LAS bf16x8*)(shb + S2_QF + (4 + kb) * 1024 + lane * 16); \
                    o00 = MFMA16(sa0, q0, o00); o01 = MFMA16(sa0, q1, o01); o10 = MFMA16(sa1, q0, o10); o11 = MFMA16(sa1, q1, o11); } } \
            float p0 = ((o00[0] * o00[0] + o00[1] * o00[1]) + (o00[2] * o00[2] + o00[3] * o00[3])) + ((o10[0] * o10[0] + o10[1] * o10[1]) + (o10[2] * o10[2] + o10[3] * o10[3])); \
            float p1 = ((o01[0] * o01[0] + o01[1] * o01[1]) + (o01[2] * o01[2] + o01[3] * o01[3])) + ((o11[0] * o11[0] + o11[1] * o11[1]) + (o11[2] * o11[2] + o11[3] * o11[3])); \
            p0 += __shfl_xor(p0, 16); p0 += __shfl_xor(p0, 32); p1 += __shfl_xor(p1, 16); p1 += __shfl_xor(p1, 32); \
            LAS float* ssw = SS + (c & 1) * 128 + k2 * 32; if (fq == 0) { ssw[fr] = p0; ssw[16 + fr] = p1; } \
            og00 = (f32x4){o00[0] * go0[0] * bflo(g00.x), o00[1] * go0[1] * bfhi(g00.x), o00[2] * go0[2] * bflo(g00.y), o00[3] * go0[3] * bfhi(g00.y)}; \
            og01 = (f32x4){o01[0] * go0[0] * bflo(g01.x), o01[1] * go0[1] * bfhi(g01.x), o01[2] * go0[2] * bflo(g01.y), o01[3] * go0[3] * bfhi(g01.y)}; \
            og10 = (f32x4){o10[0] * go1[0] * bflo(g10.x), o10[1] * go1[1] * bfhi(g10.x), o10[2] * go1[2] * bflo(g10.y), o10[3] * go1[3] * bfhi(g10.y)}; \
            og11 = (f32x4){o11[0] * go1[0] * bflo(g11.x), o11[1] * go1[1] * bfhi(g11.x), o11[2] * go1[2] * bflo(g11.y), o11[3] * go1[3] * bfhi(g11.y)}; \
        } while (0)
#define S3O_SL(s) do { S3O_STEP((s) % 6, c0 + (s)); if (POLL) S3_FCHK(F[(s) % 3], c0 + (s) + 6); S3O_LOAD((s) % 6, c0 + (s) + 6); if (POLL) F[(s) % 3] = S3_FLD(c0 + (s) + 9); } while (0)
#define S3O_TRIP(cb) do { const int c0 = (cb); S3O_SL(0); S3O_SL(1); S3O_SL(2); S3O_SL(3); S3O_SL(4); S3O_SL(5); S3O_SL(6); S3O_SL(7); S3O_SL(8); S3O_SL(9); S3O_SL(10); S3O_SL(11); } while (0)
        unsigned F[3] = {1u, 1u, 1u};
        if (POLL) { wait_flags_clamped<6>(fl, 0); F[0] = S3_FLD(6); F[1] = S3_FLD(7); F[2] = S3_FLD(8); }
        S3O_LOAD(0, 0); S3O_LOAD(1, 1); S3O_LOAD(2, 2); S3O_LOAD(3, 3); S3O_LOAD(4, 4); S3O_LOAD(5, 5);
        S3O_TRIP(0); S3O_TRIP(12); S3O_TRIP(24); S3O_TRIP(36); S3O_TRIP(48);
        S3O_STEP(0, 60); S3O_STEP(1, 61); S3O_STEP(2, 62); S3O_STEP(3, 63);
        __syncthreads();
        S3O_FINISH(63);
        __syncthreads();
#undef S3O_LOAD
#undef S3O_FINISH
#undef S3O_STEP
#undef S3O_SL
#undef S3O_TRIP
    }
#undef S3_CL
#undef S3_FLD
#undef S3_FCHK
}
__device__ __forceinline__ int mix_next_item(int j, int ob, int nb, int ng) {
    if (ng == 0) return j + nb;
    const int split = 8 * nb;
    if (j < split) { const int jn = j + nb; return (jn < split) ? jn : ((ob >= ng) ? split + (ob - ng) : 1 << 20); }
    return j + (nb - ng);
}
constexpr int GM_VT = 0, GM_WL = 34816, GM_MU = 69632;
__device__ __forceinline__ void gmlp2_item(const MixArgs& A, int b, int n, int h0, int h1, LAS unsigned char* lds, int tid) {
    LAS bf16* VT = (LAS bf16*)(lds + GM_VT); LAS bf16* WL = (LAS bf16*)(lds + GM_WL); LAS float* MU = (LAS float*)(lds + GM_MU); LAS float* RS = MU + 128;
    const int lane = tid & 63, w = tid >> 6, fr = lane & 15, fq = lane >> 4;
    const int m0_ = b * SEQ + 128 * n;
    { const int m0 = m0_;
#pragma unroll 4
    for (int r = 0; r < 16; ++r) { const size_t row = (size_t)(m0 + 16 * w + r);
        const v4u a = *(const v4u*)(A.PROJ + row * INW + 1024 + 8 * lane), c = *(const v4u*)(A.PROJ + row * INW + 1024 + 512 + 8 * lane);
        float x[16] = {bflo(a.x), bfhi(a.x), bflo(a.y), bfhi(a.y), bflo(a.z), bfhi(a.z), bflo(a.w), bfhi(a.w), bflo(c.x), bfhi(c.x), bflo(c.y), bfhi(c.y), bflo(c.z), bfhi(c.z), bflo(c.w), bfhi(c.w)};
        float s = 0.f;
#pragma unroll
        for (int i = 0; i < 16; ++i) s += x[i];
        const float mu = wave_sum(s) * (1.0f / 1024.0f); float q = 0.f;
#pragma unroll
        for (int i = 0; i < 16; ++i) { const float d = x[i] - mu; q += d * d; }
        const float rs = 1.0f / sqrtf(wave_sum(q) * (1.0f / 1024.0f) + EPS);
        if (lane == 0) { MU[16 * w + r] = mu; RS[16 * w + r] = rs; } }
    }
    __syncthreads();
    for (int h = h0; h < h1; ++h) {
        int m0 = __builtin_amdgcn_readfirstlane(m0_); asm volatile("" : "+s"(m0));
        {
            const int s = tid >> 2, dq = tid & 3; const size_t row = (size_t)(m0 + s); const float mu = MU[s], rs = RS[s];
#pragma unroll
            for (int i = 0; i < 4; ++i) { const int d0 = 32 * dq + 8 * i;
                const v4u a = *(const v4u*)(A.PROJ + row * INW + 1024 + h * 128 + d0);
                const f32x4 g0 = *(const f32x4*)(A.ln_g + h * 128 + d0), g1 = *(const f32x4*)(A.ln_g + h * 128 + d0 + 4), b0 = *(const f32x4*)(A.ln_b + h * 128 + d0), b1 = *(const f32x4*)(A.ln_b + h * 128 + d0 + 4);
                float vn[8] = {(bflo(a.x) - mu) * rs * g0[0] + b0[0], (bfhi(a.x) - mu) * rs * g0[1] + b0[1], (bflo(a.y) - mu) * rs * g0[2] + b0[2], (bfhi(a.y) - mu) * rs * g0[3] + b0[3],
                               (bflo(a.z) - mu) * rs * g1[0] + b1[0], (bfhi(a.z) - mu) * rs * g1[1] + b1[1], (bflo(a.w) - mu) * rs * g1[2] + b1[2], (bfhi(a.w) - mu) * rs * g1[3] + b1[3]};
                if (n == 15) { float* vp = A.out + OUT_VP + ((size_t)((A.l * NB + b) * 128 + s)) * 1024 + h * 128 + d0;
                    *(f32x4*)vp = (f32x4){vn[0], vn[1], vn[2], vn[3]}; *(f32x4*)(vp + 4) = (f32x4){vn[4], vn[5], vn[6], vn[7]}; }
#pragma unroll
                for (int e = 0; e < 8; ++e) VT[(d0 + e) * 136 + s] = (bf16)(pk2(vn[e], 0.f) & 0xffffu); }
        }
        {
            const int t = tid >> 2, sq = tid & 3; const float* wr = A.sw + ((size_t)h * 128 + t) * 128 + 32 * sq;
#pragma unroll
            for (int i = 0; i < 4; ++i) { const int s0 = 32 * sq + 8 * i; const f32x4 x0 = *(const f32x4*)(wr + 8 * i), x1 = *(const f32x4*)(wr + 8 * i + 4);
                v4u o; o.x = pk2(s0 + 0 <= t ? x0[0] : 0.f, s0 + 1 <= t ? x0[1] : 0.f); o.y = pk2(s0 + 2 <= t ? x0[2] : 0.f, s0 + 3 <= t ? x0[3] : 0.f);
                o.z = pk2(s0 + 4 <= t ? x1[0] : 0.f, s0 + 5 <= t ? x1[1] : 0.f); o.w = pk2(s0 + 6 <= t ? x1[2] : 0.f, s0 + 7 <= t ? x1[3] : 0.f);
                *(LAS v4u*)(WL + t * 136 + s0) = o; }
        }
        __syncthreads();
        f32x4 acc[8];
#pragma unroll
        for (int dt = 0; dt < 8; ++dt) acc[dt] = (f32x4){0.f, 0.f, 0.f, 0.f};
        const int nkb = (16 * w + 15) / 32 + 1;
        for (int kb = 0; kb < nkb; ++kb) { const bf16x8 wb = *(const LAS bf16x8*)(WL + (16 * w + fr) * 136 + 32 * kb + 8 * fq);
#pragma unroll
            for (int dt = 0; dt < 8; ++dt) { const bf16x8 va = *(const LAS bf16x8*)(VT + (16 * dt + fr) * 136 + 32 * kb + 8 * fq); acc[dt] = MFMA16(va, wb, acc[dt]); } }
        {   const int t = 16 * w + fr; const size_t row = (size_t)(m0 + t); const float bt = A.sb[h * 128 + t];
#pragma unroll
            for (int dt = 0; dt < 8; ++dt) { const v2u uu = *(const v2u*)(A.PROJ + row * INW + h * 128 + 16 * dt + 4 * fq);
                *(v2u*)(A.MIXIN + row * DM + h * 128 + 16 * dt + 4 * fq) = (v2u){pk2(bflo(uu.x) * (acc[dt][0] + bt), bfhi(uu.x) * (acc[dt][1] + bt)), pk2(bflo(uu.y) * (acc[dt][2] + bt), bfhi(uu.y) * (acc[dt][3] + bt))}; }
        }
        __syncthreads();
    }
}
__device__ __forceinline__ void hgrn_sample_loop(const MixArgs& A, int j0, int jstride, int jend, LAS unsigned char* lds, int tid) {
    if (j0 >= jend) return;
    LAS float* FK = (LAS float*)lds;
    LAS float* OPART = FK + 384;
    const int lane = tid & 63, w = tid >> 6, vq = lane & 31, par = lane >> 5;
    f32x4 sv[8];
    { const float* s0 = A.state_in + ((size_t)j0 * 128) * 128;
#pragma unroll
      for (int it = 0; it < 8; ++it) sv[it] = __builtin_nontemporal_load((const f32x4*)(s0 + (size_t)(16 * w + 2 * it + par) * 128 + 4 * vq)); }
    for (int j = j0; j < jend; j += jstride) {
        const int b = j >> 3, h = j & 7; const size_t row = (size_t)(MP + b);
        if (tid < 128) { const int k = tid; const float z = A.ZF[row * 1024 + h * 128 + k]; const float lbv = A.LB[A.l * 1024 + h * 128 + k]; const float sg = sigmoid_f(z);
            FK[k] = lbv + (1.0f - lbv) * sg; FK[128 + k] = (1.0f - lbv) * (1.0f - sg); FK[256 + k] = bf2f(A.PROJ[row * INW + 2048 + h * 128 + k]); }
        const v2u ib = *(const v2u*)(A.PROJ + row * INW + 4096 + h * 128 + 4 * vq);
        const f32x4 i4 = (f32x4){bflo(ib.x), bfhi(ib.x), bflo(ib.y), bfhi(ib.y)};
        __syncthreads();
        f32x4 cur[8];
#pragma unroll
        for (int it = 0; it < 8; ++it) cur[it] = sv[it];
        if (j + jstride < jend) { const float* s0 = A.state_in + ((size_t)(j + jstride) * 128) * 128;
#pragma unroll
            for (int it = 0; it < 8; ++it) sv[it] = __builtin_nontemporal_load((const f32x4*)(s0 + (size_t)(16 * w + 2 * it + par) * 128 + 4 * vq)); }
        float* s1 = A.out + OUT_SS + ((size_t)(A.l * MS * 8 + j) * 128) * 128;
        f32x4 o = (f32x4){0.f, 0.f, 0.f, 0.f};
#pragma unroll
        for (int it = 0; it < 8; ++it) { const int k = 16 * w + 2 * it + par; const float f = FK[k], kk = FK[128 + k], q = FK[256 + k];
            f32x4 sn; sn.x = f * cur[it].x + kk * i4.x; sn.y = f * cur[it].y + kk * i4.y; sn.z = f * cur[it].z + kk * i4.z; sn.w = f * cur[it].w + kk * i4.w;
            __builtin_nontemporal_store(sn, (f32x4*)(s1 + (size_t)k * 128 + 4 * vq));
            o.x += sn.x * q; o.y += sn.y * q; o.z += sn.z * q; o.w += sn.w * q; }
        o.x += __shfl_xor(o.x, 32); o.y += __shfl_xor(o.y, 32); o.z += __shfl_xor(o.z, 32); o.w += __shfl_xor(o.w, 32);
        if (par == 0) *(LAS f32x4*)(OPART + w * 128 + 4 * vq) = o;
        __syncthreads();
        if (w == 0) {
            float o0 = 0.f, o1 = 0.f;
#pragma unroll
            for (int g = 0; g < 8; ++g) { o0 += OPART[g * 128 + 2 * lane]; o1 += OPART[g * 128 + 2 * lane + 1]; }
            const float rstd = __builtin_amdgcn_rsqf(wave_sum(o0 * o0 + o1 * o1) * (1.0f / 128.0f) + EPS);
            const unsigned sg = *(const unsigned*)(A.PROJ + row * INW + 5120 + h * 128 + 2 * lane);
            const float g0 = A.gout[h * 128 + 2 * lane], g1 = A.gout[h * 128 + 2 * lane + 1];
            *(unsigned*)(A.MIXIN + row * DM + 1024 + h * 128 + 2 * lane) = pk2(o0 * rstd * g0 * bflo(sg), o1 * rstd * g1 * bfhi(sg));
        }
    }
    __syncthreads();
}
#define LAYER_BODY(L_) do { const int l = (L_); \
        const int pb = 1 + 5 * l; \
        if (IN(pb + 0)) { \
            { pg8::Gemm g{H, Win_t + (size_t)l * INW * DM, MP, INW, DM}; pg8::StaticOrder S; S.init(MP, INW, G, bid); \
            pg8::EpiIn E{PROJ, ZF}; \
            pg8::gemm_phase<pg8::EpiIn, pg8::StaticOrder, true, true>(lds, g, S, E); \
            if (DUP_GEMM & 1) pg8::gemm_phase<pg8::EpiIn, pg8::StaticOrder, true, true>(lds, g, S, E); \
            for (int su = bid; su < INW / 64; su += G) { \
                pg8::SEpiIn SE{PROJ + (size_t)MP * INW, ZF + (size_t)MP * AW, 64 * su}; \
                pg8::gemm_small_unit(lds, H + (size_t)MP * DM, DM, Win_t + (size_t)l * INW * DM, DM, 0, DM / 64, pg8::BRowLin{64 * su}, SE); } } \
            if (bid >= INW / 64 && G == 256) {      \
                asm volatile("s_waitcnt vmcnt(0) lgkmcnt(0)" ::: "memory"); __syncthreads(); \
                convert_layer(WP, l, (bid - INW / 64) * NWAVES + wave, (G - INW / 64) * NWAVES, (LAS float*)(lds + wave * 16384), lane, 8); } \
        } \
        SEAM(pb + 0); \
        if (IN(pb + 1)) { \
            MixArgs A; A.l = l; A.PROJ = PROJ; A.ZF = ZF; A.MIXIN = MIXIN; A.LB = LB; A.ln_g = ln_v_gain + l * 1024; A.ln_b = ln_v_bias + l * 1024; \
            A.sw = spatial_w + (size_t)l * 8 * 128 * 128; A.sb = spatial_b + l * 8 * 128; A.gout = hgrn_out_gain + l * 1024; \
            A.state_in = state_hgrn + (size_t)l * MS * 8 * 128 * 128; A.out = args.out; \
            HgArgs HA; HA.l = l; HA.PROJ = PROJ; HA.ZF = ZF; HA.LB = LB; HA.QF = HQF; HA.KET = HKET; HA.ITG = HIT; HA.OI = HOI; HA.DL = HDL; HA.MIXIN = MIXIN; HA.gout = hgrn_out_gain + l * 1024; HA.out = args.out; \
            HA.flags = (unsigned*)(ctl + CW_FLAG0) + (size_t)l * 2048 * 16; \
            if (bid < 32 && G > 32) { hgrn_scan_item3<true>(HA, bid, lds, tid); if (DUP_MIX & 2) hgrn_scan_item3<true>(HA, bid, lds, tid); } \
            else { \
                const int ob = bid - 32, nb = G - 32, ng = (nb >= 224) ? 128 : 0; \
                { int prev = -1; PreRegs PR; if (ob < 2048) hgrn_pre_load(HA, (ob & 31) * 64 + (ob >> 5), PR, tid); \
                  for (int j = ob; j < 2048; ) { const int it = (j & 31) * 64 + (j >> 5), jn = mix_next_item(j, ob, nb, ng); hgrn_pre_item(HA, it, prev, jn < 2048 ? (jn & 31) * 64 + (jn >> 5) : -1, PR, lds, tid); prev = it; j = jn; }      \
                  hgrn_pre_publish_last(HA, prev, tid); } \
                if (ng) { \
                    if (ob < ng) { gmlp2_item(A, ob >> 5, (ob >> 1) & 15, 4 * (ob & 1), 4 * (ob & 1) + 4, lds, tid); } \
                    else { if (ob - ng < 16) gmlp_sample_row(A, 8 * (ob - ng) + wave, lane); hgrn_sample_loop(A, ob - ng, nb - ng, 1024, lds, tid); } \
                } else { \
                    for (int it = ob; it < 64; it += nb) gmlp2_item(A, it >> 4, it & 15, 0, 8, lds, tid); \
                    for (int it = ob; it < 16; it += nb) gmlp_sample_row(A, 8 * it + wave, lane); \
                    hgrn_sample_loop(A, ob, nb, 1024, lds, tid); \
                } \
                if (G == 256) { asm volatile("s_waitcnt vmcnt(0) lgkmcnt(0)" ::: "memory"); __syncthreads(); convert_layer(WP, l, ob * NWAVES + wave, nb * NWAVES, (LAS float*)(lds + wave * 16384), lane, 9); }      \
            } \
        } \
        SEAM(pb + 1); \
        if (IN(pb + 2)) { \
            { pg8::Gemm g{MIXIN, Wout_t + (size_t)l * DM * DM, MP, DM, DM}; pg8::StaticOrder S; S.init(MP, DM, G, bid); \
            pg8::EpiB16WT E{MIXB, DM}; \
            pg8::gemm_phase<pg8::EpiB16WT, pg8::StaticOrder, true, true>(lds, g, S, E); \
            if (FUSE_NORM) { pg8::Unit u0; if (S.next(0, u0)) { panel_wait((unsigned*)(ctl + CW_CNT0) + ((2 * l) * 32 + u0.pm) * 16, tid); \
                const __amdgpu_buffer_rsrc_t rm = __builtin_amdgcn_make_buffer_rsrc((void*)MIXB, (short)0, 0x7fffffff, 0x00020000); \
                _Pragma("unroll") for (int i = 0; i < 2; ++i) { const size_t m = (size_t)u0.pm * 256 + u0.pn * 32 + wave * 4 + 2 * i; bf16* xo = XB + m * DM; bf16* ho = H + m * DM; \
                    if (l == 0) norm_res_row2_sc1<false>(rm, m, x_prompt + m * DM, (size_t)DM * 4, norm_mix_post + l * DM, xo, nullptr, norm_ffn_pre + l * DM, ho, lane); \
                    else norm_res_row2_sc1<true>(rm, m, xo, (size_t)DM * 2, norm_mix_post + l * DM, xo, nullptr, norm_ffn_pre + l * DM, ho, lane); } } } \
            int nsu = 0; \
            for (int su = bid; su < DM / 64; su += G) { ++nsu; \
                pg8::SEpiF32WT SE{MIXS, DM, 64 * su}; \
                pg8::gemm_small_unit(lds, MIXIN + (size_t)MP * DM, DM, Wout_t + (size_t)l * DM * DM, DM, 0, DM / 64, pg8::BRowLin{64 * su}, SE); } \
            if (G == 256 && bid >= DM / 64) {      \
                asm volatile("s_waitcnt vmcnt(0) lgkmcnt(0)" ::: "memory"); __syncthreads(); \
                convert_layer(WP, l, (bid - DM / 64) * NWAVES + wave, (G - DM / 64) * NWAVES, (LAS float*)(lds + wave * 16384), lane, 6); \
                if (l + 1 < DEPTH) convert_layer(WP, l + 1, (bid - DM / 64) * NWAVES + wave, (G - DM / 64) * NWAVES, (LAS float*)(lds + wave * 16384), lane, 10); } \
            {   unsigned* sc = (unsigned*)(ctl + CW_CNT0) + (256 + 2 * l) * 16; \
                sample_count(sc, nsu, tid); \
                if (bid >= G - 16) { sample_wait(sc, DM / 64, tid); \
                    const int m = MP + 8 * (bid - (G - 16)) + wave; bf16* xo = XB + (size_t)m * DM; bf16* ho = H + (size_t)m * DM; \
                    const __amdgpu_buffer_rsrc_t rs = __builtin_amdgcn_make_buffer_rsrc((void*)MIXS, (short)0, 0x7fffffff, 0x00020000); \
                    if (l == 0) norm_res_row_s<false>(rs, (size_t)(m - MP) * DM * 4, 1, 0, x_sample + (size_t)(m - MP) * DM, norm_mix_post + l * DM, xo, nullptr, norm_ffn_pre + l * DM, ho, lane); \
                    else norm_res_row_s<true>(rs, (size_t)(m - MP) * DM * 4, 1, 0, xo, norm_mix_post + l * DM, xo, nullptr, norm_ffn_pre + l * DM, ho, lane); } } } \
        } \
        SEAM(pb + 2); \
        if (IN(pb + 3)) { \
            { pg8::Gemm g{H, Wgu_t + (size_t)l * 2 * DFF * DM, MP, 2 * DFF, DM}; pg8::StaticOrder S; S.init(MP, 2 * DFF, G, bid); \
            pg8::EpiGU E{ACT, DFF}; \
            pg8::gemm_phase<pg8::EpiGU, pg8::StaticOrder, true, true>(lds, g, S, E); \
            if (DUP_GEMM & 2) pg8::gemm_phase<pg8::EpiGU, pg8::StaticOrder, true, true>(lds, g, S, E); \
            if (bid >= G / 2) for (int su = bid - G / 2; su < DFF / 32; su += G - G / 2) {      \
                pg8::SEpiGU SE{ACT + (size_t)MP * DFF, DFF, 32 * su}; \
                pg8::gemm_small_unit(lds, H + (size_t)MP * DM, DM, Wgu_t + (size_t)l * 2 * DFF * DM, DM, 0, DM / 64, pg8::BRowGU{su >> 2, su & 3}, SE); } } \
            if (l + 1 < DEPTH && bid >= G / 2) {      \
                asm volatile("s_waitcnt vmcnt(0) lgkmcnt(0)" ::: "memory"); __syncthreads(); \
                if (G == 256) { const int b2 = bid - 128;      \
                    if (b2 >= 48 || wave < 5) convert_layer(WP, l + 1, b2 < 48 ? b2 * 5 + wave : 240 + (b2 - 48) * 8 + wave, 880, (LAS float*)(lds + wave * 16384), lane, 11); } \
                if (DUP_CONV) convert_layer(WP, l + 1, (bid - G / 2) * NWAVES + wave, (G - G / 2) * NWAVES, (LAS float*)(lds + wave * 16384), lane, 2); } \
        } \
        SEAM(pb + 3); \
        if (IN(pb + 4)) { \
            { pg8::Gemm g{ACT, Wdn_t + (size_t)l * DM * DFF, MP, DM, DFF}; pg8::StaticOrder S; S.init(MP, DM, G, bid); \
            pg8::EpiB16WT E{MIXB, DM}; \
            pg8::gemm_phase<pg8::EpiB16WT, pg8::StaticOrder, true, true>(lds, g, S, E); \
            if (FUSE_NORM) { pg8::Unit u0; if (S.next(0, u0)) { panel_wait((unsigned*)(ctl + CW_CNT0) + ((2 * l + 1) * 32 + u0.pm) * 16, tid); \
                const __amdgpu_buffer_rsrc_t rm = __builtin_amdgcn_make_buffer_rsrc((void*)MIXB, (short)0, 0x7fffffff, 0x00020000); \
                const bool last = (l == DEPTH - 1); const float* gp = last ? nullptr : norm_mix_pre + (l + 1) * DM; \
                _Pragma("unroll") for (int i = 0; i < 2; ++i) { const size_t m = (size_t)u0.pm * 256 + u0.pn * 32 + wave * 4 + 2 * i; bf16* xo = XB + m * DM; \
                    norm_res_row2_sc1<true>(rm, m, xo, (size_t)DM * 2, norm_ffn_post + l * DM, last ? nullptr : xo, last ? args.out + OUT_Y + m * DM : nullptr, gp, last ? nullptr : H + m * DM, lane); } } } \
            int nsu = 0; \
            for (int su = bid; su < 4 * (DM / 64); su += G) { ++nsu;      \
                const int ks = su & 3, nt = su >> 2; \
                pg8::SEpiF32WT SE{MIXS + (size_t)ks * MS * DM, DM, 64 * nt}; \
                pg8::gemm_small_unit(lds, ACT + (size_t)MP * DFF, DFF, Wdn_t + (size_t)l * DM * DFF, DFF, ks * (DFF / 4), DFF / 4 / 64, pg8::BRowLin{64 * nt}, SE); } \
            {   unsigned* sc = (unsigned*)(ctl + CW_CNT0) + (256 + 2 * l + 1) * 16; \
                sample_count(sc, nsu, tid); \
                if (bid >= G - 16) { sample_wait(sc, 4 * (DM / 64), tid); \
                    const bool last = (l == DEPTH - 1); \
                    const int m = MP + 8 * (bid - (G - 16)) + wave; bf16* xo = XB + (size_t)m * DM; \
                    const __amdgpu_buffer_rsrc_t rs = __builtin_amdgcn_make_buffer_rsrc((void*)MIXS, (short)0, 0x7fffffff, 0x00020000); \
                    norm_res_row_s<true>(rs, (size_t)(m - MP) * DM * 4, 4, (size_t)MS * DM * 4, xo, norm_ffn_post + l * DM, last ? nullptr : xo, last ? args.out + OUT_Y + (size_t)m * DM : nullptr, \
                                         last ? nullptr : norm_mix_pre + (l + 1) * DM, last ? nullptr : H + (size_t)m * DM, lane); } } } \
        } \
        SEAM(pb + 4); \
    } while (0)
struct Args { const float* in[18]; float* out; unsigned char* ws; int ph_lo, ph_hi; };
constexpr int NPHASE = 1 + 5 * DEPTH;
__global__ void __launch_bounds__(NWAVES * 64, 2) mk_fwd(Args args) {
    extern __shared__ __attribute__((aligned(16))) unsigned char lds_raw[];
    LAS unsigned char* lds = (LAS unsigned char*)lds_raw;
    volatile LAS unsigned* MISC = (volatile LAS unsigned*)(lds + MISC_OFF);
    const int tid = threadIdx.x, lane = tid & 63, wave = __builtin_amdgcn_readfirstlane(tid >> 6);
    const int G = gridDim.x, bid = blockIdx.x;
    unsigned char* ws = args.ws;
    gu32* ctl = (gu32*)(ws + WS_CTL);
    for (int u = tid; u < (LDS_BYTES - LDSCTL_OFF) / 4; u += NWAVES * 64) ((LAS unsigned*)(lds + LDSCTL_OFF))[u] = 0u;
    __syncthreads();
#if MK_MULTI
    XcdBarrier bar; bar.bar = (unsigned*)(ctl + CW_BAR); bar.x = 0; bar.st = nullptr;
#define GRID_BAR() do { } while (0)
#else
    XcdBarrier bar = xcd_barrier_post((unsigned*)(ctl + CW_BAR), MISC + 8);
#define GRID_BAR() xcd_barrier(bar)
#endif
    const int lo = args.ph_lo, hi = args.ph_hi;
#define IN(k) (lo <= (k) && (k) < hi)
#define SEAM(k) do { if (IN(k) && IN((k) + 1)) GRID_BAR(); } while (0)
    const float* x_prompt = args.in[0]; const float* x_sample = args.in[1]; const float* state_hgrn = args.in[2];
    const float* norm_mix_pre = args.in[3]; const float* norm_mix_post = args.in[4]; const float* w_in = args.in[5];
    const float* ln_v_gain = args.in[6]; const float* ln_v_bias = args.in[7]; const float* spatial_w = args.in[8]; const float* spatial_b = args.in[9];
    const float* lb_param = args.in[10]; const float* hgrn_out_gain = args.in[11]; const float* w_out = args.in[12];
    const float* norm_ffn_pre = args.in[13]; const float* norm_ffn_post = args.in[14]; const float* w_gate = args.in[15]; const float* w_up = args.in[16]; const float* w_down = args.in[17];
    bf16* Win_t = (bf16*)(ws + WS_WIN); bf16* Wout_t = (bf16*)(ws + WS_WOUT); bf16* Wgu_t = (bf16*)(ws + WS_WGU); bf16* Wdn_t = (bf16*)(ws + WS_WDN);
    bf16* XB = (bf16*)(ws + WS_X); bf16* MIXB = (bf16*)(ws + WS_MIX); bf16* H = (bf16*)(ws + WS_H); bf16* PROJ = (bf16*)(ws + WS_PROJ); float* ZF = (float*)(ws + WS_ZF);
    bf16* MIXIN = (bf16*)(ws + WS_MIXIN); bf16* ACT = (bf16*)(ws + WS_ACT); float* LB = (float*)(ws + WS_LB); float* MIXS = (float*)(ws + WS_MIXS);
    bf16* HQF = (bf16*)(ws + WS_HQF); bf16* HKET = (bf16*)(ws + WS_HKET); bf16* HIT = (bf16*)(ws + WS_HIT); bf16* HOI = (bf16*)(ws + WS_HOI); float* HDL = (float*)(ws + WS_HDL);
    const int gw = bid * NWAVES + wave, NGW = G * NWAVES;
    WPtrs WP; WP.w_in = w_in; WP.w_out = w_out; WP.w_gate = w_gate; WP.w_up = w_up; WP.w_down = w_down; WP.Win_t = Win_t; WP.Wout_t = Wout_t; WP.Wgu_t = Wgu_t; WP.Wdn_t = Wdn_t;

    if (IN(0)) {
        if (G == 256) convert_layer(WP, 0, gw, NGW, (LAS float*)(lds + wave * 16384), lane, 1);
        else for (int ll = 0; ll < DEPTH; ++ll) convert_layer(WP, ll, gw, NGW, (LAS float*)(lds + wave * 16384), lane, 0);
        for (int c = bid * 512 + tid; c < 1024; c += G * 512) {
            const float a0 = lb_param[c], a1 = lb_param[1024 + c], a2 = lb_param[2048 + c], a3 = lb_param[3072 + c];
            const float mx = fmaxf(fmaxf(a0, a1), fmaxf(a2, a3));
            const float e0 = expf(a0 - mx), e1 = expf(a1 - mx), e2 = expf(a2 - mx), e3 = expf(a3 - mx); const float inv = 1.0f / (e0 + e1 + e2 + e3);
            LB[c] = 0.f; LB[1024 + c] = e1 * inv; LB[2048 + c] = (e1 + e2) * inv; LB[3072 + c] = (e1 + e2 + e3) * inv;
        }
        for (int m = gw; m < MREAL; m += NGW) { const float* xr = (m < MP) ? x_prompt + (size_t)m * DM : x_sample + (size_t)(m - MP) * DM; norm_in_row(xr, norm_mix_pre, H + (size_t)m * DM, lane); }
    }
    SEAM(0);
    LAYER_BODY(0); LAYER_BODY(1); LAYER_BODY(2); LAYER_BODY(3);
#undef IN
#undef SEAM
}

extern "C" void kernel_launch(void* const* d_in, const int* in_sizes, int n_in, void* d_out, int out_size, void* d_ws, size_t ws_size, hipStream_t stream) {
    static int grid = 0;
    if (grid == 0) {
        if (n_in != 18 || (size_t)out_size != OUT_TOTAL || ws_size < WS_END) { fprintf(stderr, "kernel_launch: unexpected shapes (n_in %d out %d ws %zu)\n", n_in, out_size, ws_size); grid = -1; return; }
        int dev = 0, cus = 0, per_cu = 0;
        if (hipGetDevice(&dev) != hipSuccess || hipDeviceGetAttribute(&cus, hipDeviceAttributeMultiprocessorCount, dev) != hipSuccess) { grid = -1; return; }
        if (hipFuncSetAttribute((const void*)mk_fwd, hipFuncAttributeMaxDynamicSharedMemorySize, LDS_BYTES) != hipSuccess) { grid = -1; return; }
        if (hipOccupancyMaxActiveBlocksPerMultiprocessor(&per_cu, (const void*)mk_fwd, NWAVES * 64, LDS_BYTES) != hipSuccess || per_cu < 1) { fprintf(stderr, "kernel_launch: occupancy query says %d\n", per_cu); }
        (void)hipGetLastError();
        grid = cus;
    }
    if (grid < 0) return;
    (void)hipMemsetAsync((char*)d_ws + WS_CTL, 0, CTL_ZERO_BYTES, stream);
    Args a{};
    for (int i = 0; i < 18; ++i) a.in[i] = (const float*)d_in[i];
    a.out = (float*)d_out; a.ws = (unsigned char*)d_ws;
#if MK_MULTI
    for (int p = 0; p < NPHASE; ++p) { a.ph_lo = p; a.ph_hi = p + 1; hipLaunchKernelGGL(mk_fwd, dim3(grid), dim3(NWAVES * 64), LDS_BYTES, stream, a); }
#else
    a.ph_lo = 0; a.ph_hi = NPHASE;
    hipLaunchKernelGGL(mk_fwd, dim3(grid), dim3(NWAVES * 64), LDS_BYTES, stream, a);
#endif
}
```
